# Optimizing an MI355X kernel written in HIP

```python
import math
import jax, jax.numpy as jnp
from jax import lax
import numpy as np

D_MODEL = 1024
BATCH = 8
SEQ = 4096
DEPTH = 2

HEAD_DIM = 64
N_HEADS_DIL = 8
N_HEADS_WIN = 8
N_KV_WIN = 2
DIL_PATTERNS = ((128, 1), (512, 4), (2048, 16))
WIN_SIDE = 128
WIN_BLOCK = 128
D_DIL = N_HEADS_DIL * HEAD_DIM
D_WIN = N_HEADS_WIN * HEAD_DIM
D_KV_WIN = N_KV_WIN * HEAD_DIM
MIX_WIDTH = D_DIL + D_WIN
IN_COLS = 3 * D_DIL + D_WIN + 2 * D_KV_WIN
D_FF = ((8 * D_MODEL + 3 * 256 - 1) // (3 * 256)) * 256
EPS = 1e-6
NEG = -1e30
N_ALIBI = N_HEADS_WIN + N_HEADS_DIL

kernel_name = "hybrid_dilated_window_sink_encoder"


def rmsnorm(x, g):
    xf = x.astype(jnp.float32)
    y = xf * lax.rsqrt(jnp.mean(xf * xf, axis=-1, keepdims=True) + EPS)
    return (y * g.astype(jnp.float32)).astype(x.dtype)


def alibi_slopes(n):
    return np.array([2.0 ** (-8.0 * (i + 1) / n) for i in range(n)], dtype=np.float32)


def band_partial(q, k, v, side, blk, slopes, dist_scale):
    B, L, Hq, Dh = q.shape
    Hk = k.shape[2]
    grp = Hq // Hk
    n_blk = -(-L // blk)
    Lp = n_blk * blk
    pad = Lp - L
    qp = jnp.pad(q, ((0, 0), (0, pad), (0, 0), (0, 0))).reshape(B, n_blk, blk, Hk, grp, Dh)
    kp = jnp.pad(k, ((0, 0), (blk, pad + blk), (0, 0), (0, 0))).reshape(B, n_blk + 2, blk, Hk, Dh)
    vp = jnp.pad(v, ((0, 0), (blk, pad + blk), (0, 0), (0, 0))).reshape(B, n_blk + 2, blk, Hk, Dh)
    kw = jnp.concatenate([kp[:, 0:n_blk], kp[:, 1:n_blk + 1], kp[:, 2:n_blk + 2]], axis=2)
    vw = jnp.concatenate([vp[:, 0:n_blk], vp[:, 1:n_blk + 1], vp[:, 2:n_blk + 2]], axis=2)
    i_idx = np.arange(blk)[:, None]
    j_idx = np.arange(3 * blk)[None, :]
    rel = j_idx - blk - i_idx
    kpos = np.arange(n_blk)[:, None] * blk - blk + np.arange(3 * blk)[None, :]
    valid = (np.abs(rel) <= side)[None] & ((kpos >= 0) & (kpos < L))[:, None, :]
    dist = jnp.asarray(np.abs(rel).astype(np.float32) * dist_scale)
    sl = slopes.astype(jnp.float32).reshape(Hk, grp)
    s = jnp.einsum('bnqhgd,bnkhd->bhgnqk', qp.astype(jnp.float32), kw.astype(jnp.float32)) * (HEAD_DIM ** -0.5)
    s = s - sl[:, :, None, None, None] * dist[None, None, None]
    s = jnp.where(jnp.asarray(valid)[None, None, None], s, NEG)
    m = jnp.max(s, axis=-1)
    p = jnp.exp(s - m[..., None])
    l = jnp.sum(p, axis=-1)
    o = jnp.einsum('bhgnqk,bnkhd->bnqhgd', p, vw.astype(jnp.float32))
    m = m.transpose(0, 3, 4, 1, 2).reshape(B, Lp, Hq)[:, :L]
    l = l.transpose(0, 3, 4, 1, 2).reshape(B, Lp, Hq)[:, :L]
    o = o.reshape(B, Lp, Hq, Dh)[:, :L]
    return m, l, o


def dilated_attention(q, k, v, slopes):
    B, S, H, Dh = q.shape
    ms, ls, os_ = [], [], []
    for window, dil in DIL_PATTERNS:
        side = window // (2 * dil)
        L = S // dil

        def to_res(t):
            return t.reshape(B, L, dil, H, Dh).transpose(0, 2, 1, 3, 4).reshape(B * dil, L, H, Dh)

        m, l, o = band_partial(to_res(q), to_res(k), to_res(v), side, side, slopes, float(dil))
        ms.append(m.reshape(B, dil, L, H).transpose(0, 2, 1, 3).reshape(B, S, H))
        ls.append(l.reshape(B, dil, L, H).transpose(0, 2, 1, 3).reshape(B, S, H))
        os_.append(o.reshape(B, dil, L, H, Dh).transpose(0, 2, 1, 3, 4).reshape(B, S, H, Dh))
    m_all = jnp.stack(ms)
    l_all = jnp.stack(ls)
    o_all = jnp.stack(os_)
    w = jnp.exp(m_all - jnp.max(m_all, axis=0, keepdims=True))
    num = jnp.sum(w[..., None] * o_all, axis=0)
    den = jnp.sum(w * l_all, axis=0)
    return num / den[..., None]


def window_gqa_sink(q, k, v, slopes, sink):
    m, l, o = band_partial(q, k, v, WIN_SIDE, WIN_BLOCK, slopes, 1.0)
    sk = sink.astype(jnp.float32)
    M = jnp.maximum(m, sk)
    a = jnp.exp(m - M)
    den = l * a + jnp.exp(sk - M)
    return o * (a / den)[..., None]


def setup_inputs(seed: int = 0) -> dict:
    key = jax.random.key(seed)
    ks = jax.random.split(key, 12)
    f32 = jnp.float32
    x = jax.random.normal(ks[0], (BATCH, SEQ, D_MODEL), f32)
    g_mix = 1.0 + 0.02 * jax.random.normal(ks[1], (DEPTH, D_MODEL), f32)
    w_in = jax.random.normal(ks[2], (DEPTH, D_MODEL, IN_COLS), f32) * D_MODEL ** -0.5
    g_out_dil = 1.0 + 0.02 * jax.random.normal(ks[3], (DEPTH, D_DIL), f32)
    g_out_win = 1.0 + 0.02 * jax.random.normal(ks[4], (DEPTH, D_WIN), f32)
    sink = 0.1 * jax.random.normal(ks[5], (DEPTH, N_HEADS_WIN), f32)
    w_out = jax.random.normal(ks[6], (DEPTH, MIX_WIDTH, D_MODEL), f32) * MIX_WIDTH ** -0.5
    g_ffn = 1.0 + 0.02 * jax.random.normal(ks[7], (DEPTH, D_MODEL), f32)
    w_gate = jax.random.normal(ks[8], (DEPTH, D_MODEL, D_FF), f32) * D_MODEL ** -0.5
    w_up = jax.random.normal(ks[9], (DEPTH, D_MODEL, D_FF), f32) * D_MODEL ** -0.5
    w_down = jax.random.normal(ks[10], (DEPTH, D_FF, D_MODEL), f32) * D_FF ** -0.5
    g_final = 1.0 + 0.02 * jax.random.normal(ks[11], (D_MODEL,), f32)
    return {"x": x, "g_mix": g_mix, "w_in": w_in, "g_out_dil": g_out_dil, "g_out_win": g_out_win,
            "sink": sink, "w_out": w_out, "g_ffn": g_ffn, "w_gate": w_gate, "w_up": w_up,
            "w_down": w_down, "g_final": g_final}


def reference(x, g_mix, w_in, g_out_dil, g_out_win, sink, w_out, g_ffn, w_gate, w_up, w_down, g_final):
    B, S, _ = x.shape
    slopes = jnp.asarray(alibi_slopes(N_ALIBI))
    slopes_win = slopes[:N_HEADS_WIN]
    slopes_dil = slopes[N_HEADS_WIN:]
    o1 = D_DIL
    o2 = 2 * D_DIL
    o3 = 3 * D_DIL
    o4 = o3 + D_WIN
    o5 = o4 + D_KV_WIN
    for i in range(DEPTH):
        h = rmsnorm(x, g_mix[i])
        proj = h @ w_in[i]
        qa = proj[..., :o1].reshape(B, S, N_HEADS_DIL, HEAD_DIM)
        ka = proj[..., o1:o2].reshape(B, S, N_HEADS_DIL, HEAD_DIM)
        va = proj[..., o2:o3].reshape(B, S, N_HEADS_DIL, HEAD_DIM)
        qb = proj[..., o3:o4].reshape(B, S, N_HEADS_WIN, HEAD_DIM)
        kb = proj[..., o4:o5].reshape(B, S, N_KV_WIN, HEAD_DIM)
        vb = proj[..., o5:].reshape(B, S, N_KV_WIN, HEAD_DIM)
        ya = dilated_attention(qa, ka, va, slopes_dil).reshape(B, S, D_DIL).astype(x.dtype)
        yb = window_gqa_sink(qb, kb, vb, slopes_win, sink[i]).reshape(B, S, D_WIN).astype(x.dtype)
        y = jnp.concatenate([rmsnorm(ya, g_out_dil[i]), rmsnorm(yb, g_out_win[i])], axis=-1)
        x = x + y @ w_out[i]
        h = rmsnorm(x, g_ffn[i])
        x = x + (jax.nn.silu(h @ w_gate[i]) * (h @ w_up[i])) @ w_down[i]
    return rmsnorm(x, g_final)
```

```cpp
#include <hip/hip_runtime.h>
#include <cstdio>
#include <cstdint>

constexpr int D_MODEL = 1024, BATCH = 8, SEQ = 4096, DEPTH = 2, HD = 64;
constexpr int M_TOK = BATCH * SEQ;
constexpr int IN_COLS = 2304, D_FF = 2816;
constexpr float EPS = 1e-6f;
constexpr size_t MiB = 1u << 20;
constexpr size_t WS_XB = 0, WS_PROJ = 64 * MiB, WS_Y = 208 * MiB, WS_ACT = 272 * MiB, WS_END = 448 * MiB;
typedef unsigned short bf16;

__device__ __forceinline__ float bf2f(bf16 v) { return __uint_as_float((unsigned)v << 16); }
__device__ __forceinline__ bf16 f2bf(float f) { unsigned u = __float_as_uint(f); return (bf16)((u + 0x7fffu + ((u >> 16) & 1u)) >> 16); }
__device__ __forceinline__ float wave_sum(float v) {
#pragma unroll
    for (int o = 1; o < 64; o <<= 1) v += __shfl_xor(v, o);
    return v;
}

__global__ __launch_bounds__(256) void k_rmsnorm_bf16(const float* __restrict__ x, const float* __restrict__ g, bf16* __restrict__ out, int rows) {
    const int row = blockIdx.x * 4 + (threadIdx.x >> 6), lane = threadIdx.x & 63;
    if (row >= rows) return;
    const float4* xr = (const float4*)(x + (size_t)row * D_MODEL);
    float4 v[4]; float s = 0.f;
#pragma unroll
    for (int j = 0; j < 4; ++j) { v[j] = xr[lane + 64 * j]; s += v[j].x * v[j].x + v[j].y * v[j].y + v[j].z * v[j].z + v[j].w * v[j].w; }
    const float rstd = rsqrtf(wave_sum(s) * (1.f / D_MODEL) + EPS);
#pragma unroll
    for (int j = 0; j < 4; ++j) {
        const float4 gv = ((const float4*)g)[lane + 64 * j];
        bf16* o = out + (size_t)row * D_MODEL + (lane + 64 * j) * 4;
        o[0] = f2bf(v[j].x * rstd * gv.x); o[1] = f2bf(v[j].y * rstd * gv.y); o[2] = f2bf(v[j].z * rstd * gv.z); o[3] = f2bf(v[j].w * rstd * gv.w);
    }
}
__global__ __launch_bounds__(256) void k_rmsnorm_final(float* __restrict__ x, const float* __restrict__ g, int rows) {
    const int row = blockIdx.x * 4 + (threadIdx.x >> 6), lane = threadIdx.x & 63;
    if (row >= rows) return;
    float4* xr = (float4*)(x + (size_t)row * D_MODEL);
    float4 v[4]; float s = 0.f;
#pragma unroll
    for (int j = 0; j < 4; ++j) { v[j] = xr[lane + 64 * j]; s += v[j].x * v[j].x + v[j].y * v[j].y + v[j].z * v[j].z + v[j].w * v[j].w; }
    const float rstd = rsqrtf(wave_sum(s) * (1.f / D_MODEL) + EPS);
#pragma unroll
    for (int j = 0; j < 4; ++j) {
        const float4 gv = ((const float4*)g)[lane + 64 * j];
        float4 o; o.x = v[j].x * rstd * gv.x; o.y = v[j].y * rstd * gv.y; o.z = v[j].z * rstd * gv.z; o.w = v[j].w * rstd * gv.w;
        xr[lane + 64 * j] = o;
    }
}
__global__ __launch_bounds__(256) void k_rmsnorm_groups(const float* __restrict__ yt, const float* __restrict__ g_dil, const float* __restrict__ g_win, bf16* __restrict__ y, int rows) {
    const int row = blockIdx.x * 4 + (threadIdx.x >> 6), lane = threadIdx.x & 63;
    if (row >= rows) return;
    const float4* xr = (const float4*)(yt + (size_t)row * D_MODEL);
#pragma unroll
    for (int grp = 0; grp < 2; ++grp) {
        float4 v[2]; float s = 0.f;
#pragma unroll
        for (int j = 0; j < 2; ++j) { v[j] = xr[grp * 128 + lane + 64 * j]; s += v[j].x * v[j].x + v[j].y * v[j].y + v[j].z * v[j].z + v[j].w * v[j].w; }
        const float rstd = rsqrtf(wave_sum(s) * (1.f / 512.f) + EPS);
        const float4* g = (const float4*)(grp == 0 ? g_dil : g_win);
#pragma unroll
        for (int j = 0; j < 2; ++j) {
            const float4 gv = g[lane + 64 * j];
            bf16* o = y + (size_t)row * D_MODEL + grp * 512 + (lane + 64 * j) * 4;
            o[0] = f2bf(v[j].x * rstd * gv.x); o[1] = f2bf(v[j].y * rstd * gv.y); o[2] = f2bf(v[j].z * rstd * gv.z); o[3] = f2bf(v[j].w * rstd * gv.w);
        }
    }
}

template <int EPI>
__global__ __launch_bounds__(256) void k_gemm(const bf16* __restrict__ A, const float* __restrict__ W, const float* __restrict__ W2, int M, int N, int K, bf16* __restrict__ outb, float* __restrict__ xres) {
    __shared__ float As[16][68];
    __shared__ float Bs[16][68];
    __shared__ float Bs2[EPI == 2 ? 16 : 1][68];
    const int tid = threadIdx.x, tx = tid & 15, ty = tid >> 4;
    const int row0 = blockIdx.y * 64, col0 = blockIdx.x * 64;
    float acc[4][4], acc2[4][4];
#pragma unroll
    for (int i = 0; i < 4; ++i)
#pragma unroll
        for (int j = 0; j < 4; ++j) { acc[i][j] = 0.f; acc2[i][j] = 0.f; }
    for (int k0 = 0; k0 < K; k0 += 16) {
        {
            const int r = tid >> 2, kc = (tid & 3) * 4;
            const bf16* ap = A + (size_t)(row0 + r) * K + k0 + kc;
            const uint2 raw = *(const uint2*)ap;
            As[kc + 0][r] = __uint_as_float(raw.x << 16); As[kc + 1][r] = __uint_as_float(raw.x & 0xffff0000u);
            As[kc + 2][r] = __uint_as_float(raw.y << 16); As[kc + 3][r] = __uint_as_float(raw.y & 0xffff0000u);
        }
        {
            const int kr = tid >> 4, c = (tid & 15) * 4;
            const float4 w = *(const float4*)(W + (size_t)(k0 + kr) * N + col0 + c);
            Bs[kr][c] = w.x; Bs[kr][c + 1] = w.y; Bs[kr][c + 2] = w.z; Bs[kr][c + 3] = w.w;
            if (EPI == 2) { const float4 w2 = *(const float4*)(W2 + (size_t)(k0 + kr) * N + col0 + c);
                Bs2[kr][c] = w2.x; Bs2[kr][c + 1] = w2.y; Bs2[kr][c + 2] = w2.z; Bs2[kr][c + 3] = w2.w; }
        }
        __syncthreads();
#pragma unroll
        for (int k = 0; k < 16; ++k) {
            float a[4], b[4], b2[4];
#pragma unroll
            for (int i = 0; i < 4; ++i) { a[i] = As[k][ty * 4 + i]; b[i] = Bs[k][tx * 4 + i]; b2[i] = (EPI == 2) ? Bs2[k][tx * 4 + i] : 0.f; }
#pragma unroll
            for (int i = 0; i < 4; ++i)
#pragma unroll
                for (int j = 0; j < 4; ++j) { acc[i][j] += a[i] * b[j]; if (EPI == 2) acc2[i][j] += a[i] * b2[j]; }
        }
        __syncthreads();
    }
#pragma unroll
    for (int i = 0; i < 4; ++i) {
        const size_t off = (size_t)(row0 + ty * 4 + i) * N + col0 + tx * 4;
#pragma unroll
        for (int j = 0; j < 4; ++j) {
            if (EPI == 0) outb[off + j] = f2bf(acc[i][j]);
            else if (EPI == 1) xres[off + j] += acc[i][j];
            else { const float g = acc[i][j], u = acc2[i][j]; outb[off + j] = f2bf(g / (1.f + __expf(-g)) * u); }
        }
    }
}

__global__ __launch_bounds__(64) void k_attn_naive(const bf16* __restrict__ proj, const float* __restrict__ sink, float* __restrict__ yt) {
    const int gid = blockIdx.x * 64 + threadIdx.x;
    const int h16 = gid / M_TOK, tok = gid % M_TOK;
    const int b = tok / SEQ, t = tok % SEQ;
    const bool dil_grp = h16 < 8;
    const int h = dil_grp ? h16 : h16 - 8;
    const int qoff = dil_grp ? h * 64 : 1536 + h * 64;
    const int koff = dil_grp ? 512 + h * 64 : 2048 + (h >> 2) * 64;
    const int voff = dil_grp ? 1024 + h * 64 : 2176 + (h >> 2) * 64;
    const float slope = exp2f(-0.5f * (float)((dil_grp ? 8 + h : h) + 1));
    float q[64], o[64];
    const bf16* qp = proj + (size_t)tok * IN_COLS + qoff;
#pragma unroll
    for (int d = 0; d < 64; ++d) { q[d] = bf2f(qp[d]) * 0.125f; o[d] = 0.f; }
    float m, l;
    if (dil_grp) { m = -1e30f; l = 0.f; } else { m = sink[h]; l = 1.f; }
    const int npat = dil_grp ? 3 : 1;
    for (int p = 0; p < npat; ++p) {
        const int dil = dil_grp ? (p == 0 ? 1 : (p == 1 ? 4 : 16)) : 1;
        const int side = dil_grp ? 64 : 128;
        for (int j = -side; j <= side; ++j) {
            const int t2 = t + dil * j;
            if (t2 < 0 || t2 >= SEQ) continue;
            const bf16* kp = proj + (size_t)(b * SEQ + t2) * IN_COLS + koff;
            float s = 0.f;
#pragma unroll
            for (int d = 0; d < 64; d += 2) { const unsigned raw = *(const unsigned*)(kp + d); s += q[d] * __uint_as_float(raw << 16) + q[d + 1] * __uint_as_float(raw & 0xffff0000u); }
            s -= slope * (float)((j < 0 ? -j : j) * dil);
            const float mn = fmaxf(m, s), a = __expf(m - mn), pz = __expf(s - mn);
            l = l * a + pz; m = mn;
            const bf16* vp = proj + (size_t)(b * SEQ + t2) * IN_COLS + voff;
#pragma unroll
            for (int d = 0; d < 64; d += 2) { const unsigned raw = *(const unsigned*)(vp + d); o[d] = o[d] * a + pz * __uint_as_float(raw << 16); o[d + 1] = o[d + 1] * a + pz * __uint_as_float(raw & 0xffff0000u); }
        }
    }
    const float inv = 1.f / l;
    float* yp = yt + (size_t)tok * D_MODEL + h16 * 64;
#pragma unroll
    for (int d = 0; d < 64; ++d) yp[d] = o[d] * inv;
}

extern "C" void kernel_launch(void* const* d_in, const int* in_sizes, int n_in, void* d_out, int out_size, void* d_ws, size_t ws_size, hipStream_t stream) {
    if (n_in != 12 || out_size != M_TOK * D_MODEL || ws_size < WS_END) { fprintf(stderr, "kernel_launch: unexpected sizes n_in %d out %d ws %zu\n", n_in, out_size, ws_size); return; }
    const float* x = (const float*)d_in[0]; const float* g_mix = (const float*)d_in[1]; const float* w_in = (const float*)d_in[2];
    const float* g_out_dil = (const float*)d_in[3]; const float* g_out_win = (const float*)d_in[4]; const float* sink = (const float*)d_in[5];
    const float* w_out = (const float*)d_in[6]; const float* g_ffn = (const float*)d_in[7]; const float* w_gate = (const float*)d_in[8];
    const float* w_up = (const float*)d_in[9]; const float* w_down = (const float*)d_in[10]; const float* g_final = (const float*)d_in[11];
    float* xr = (float*)d_out; unsigned char* ws = (unsigned char*)d_ws;
    bf16* XB = (bf16*)(ws + WS_XB); bf16* PROJ = (bf16*)(ws + WS_PROJ); bf16* Y = (bf16*)(ws + WS_Y); bf16* ACT = (bf16*)(ws + WS_ACT); float* YT = (float*)(ws + WS_ACT);
    hipMemcpyAsync(xr, x, (size_t)M_TOK * D_MODEL * 4, hipMemcpyDeviceToDevice, stream);
    for (int L = 0; L < DEPTH; ++L) {
        k_rmsnorm_bf16<<<M_TOK / 4, 256, 0, stream>>>(xr, g_mix + L * D_MODEL, XB, M_TOK);
        k_gemm<0><<<dim3(IN_COLS / 64, M_TOK / 64), 256, 0, stream>>>(XB, w_in + (size_t)L * D_MODEL * IN_COLS, nullptr, M_TOK, IN_COLS, D_MODEL, PROJ, nullptr);
        k_attn_naive<<<M_TOK * 16 / 64, 64, 0, stream>>>(PROJ, sink + L * 8, YT);
        k_rmsnorm_groups<<<M_TOK / 4, 256, 0, stream>>>(YT, g_out_dil + L * 512, g_out_win + L * 512, Y, M_TOK);
        k_gemm<1><<<dim3(D_MODEL / 64, M_TOK / 64), 256, 0, stream>>>(Y, w_out + (size_t)L * D_MODEL * D_MODEL, nullptr, M_TOK, D_MODEL, D_MODEL, nullptr, xr);
        k_rmsnorm_bf16<<<M_TOK / 4, 256, 0, stream>>>(xr, g_ffn + L * D_MODEL, XB, M_TOK);
        k_gemm<2><<<dim3(D_FF / 64, M_TOK / 64), 256, 0, stream>>>(XB, w_gate + (size_t)L * D_MODEL * D_FF, w_up + (size_t)L * D_MODEL * D_FF, M_TOK, D_FF, D_MODEL, ACT, nullptr);
        k_gemm<1><<<dim3(D_MODEL / 64, M_TOK / 64), 256, 0, stream>>>(ACT, w_down + (size_t)L * D_FF * D_MODEL, nullptr, M_TOK, D_MODEL, D_FF, nullptr, xr);
    }
    k_rmsnorm_final<<<M_TOK / 4, 256, 0, stream>>>(xr, g_final, M_TOK);
}
```

```cpp
#define MK_ONE_LAUNCH 1
#include <hip/hip_runtime.h>
#include <cstdio>
#include <cstdint>
namespace pg8 {
#define PG8_LAS __attribute__((address_space(3)))
typedef unsigned short bf16_t;
typedef short bf16x8 __attribute__((ext_vector_type(8)));
typedef float f32x4 __attribute__((ext_vector_type(4)));
typedef unsigned u32x4 __attribute__((ext_vector_type(4)));
constexpr int BM = 256, BK = 64, HALF = 128, HTB = HALF * BK * 2  , STAGE_BYTES = 8 * HTB, NXCD = 8, WGM = 8;

__host__ __device__ __forceinline__ int lds_byte(int r, int c) { const int st = (r >> 4) * 2 + (c >> 5), rr = r & 15, cc = c & 31, ob = rr * 64 + cc * 2; return st * 1024 + (ob ^ (((ob >> 9) & 1) << 5)); }
__host__ __device__ __forceinline__ void stage_rc(int b, int& R, int& C) { const int st = b / 1024, sb = b % 1024, swz = sb ^ (((sb >> 9) & 1) << 5); R = (st >> 1) * 16 + swz / 64; C = (st & 1) * 32 + (swz % 64) / 2; }
__host__ __device__ __forceinline__ int perm32(int rho) { const int n = rho >> 4, i = rho & 15; return 8 * (i >> 2) + 4 * n + (i & 3); }

struct Unit { int pm, pn; };
struct Gemm { const bf16_t* A; const bf16_t* Bt; int M, N, K; };

struct StaticOrder {
    int nM, nN, nwg, G, c;
    __host__ __device__ void init(int M, int N, int G_, int c_) { nM = M / BM; nN = N / BM; nwg = nM * nN; G = G_; c = c_; }
    __host__ __device__ bool next(int i, Unit& u) const {
        const long L = (long)i * G + c; if (L >= nwg) return false;
        int wgid = (int)L; { const int q = nwg / NXCD, r = nwg % NXCD, xcd = wgid % NXCD, off = wgid / NXCD; wgid = (xcd < r ? xcd * (q + 1) : r * (q + 1) + (xcd - r) * q) + off; }
        const int nig = WGM * nN, gid = wgid / nig, fm = gid * WGM, gsz = (nM - fm) < WGM ? (nM - fm) : WGM;
        u.pm = fm + ((wgid % nig) % gsz); u.pn = (wgid % nig) / gsz; return true;
    }
    __device__ __forceinline__ void a_ready(const Unit&) const {}
    __device__ __forceinline__ void done(const Unit&) const {}
};


__device__ __forceinline__ unsigned cvt_pk_bf16(float lo, float hi) { unsigned r; asm volatile("v_cvt_pk_bf16_f32 %0, %1, %2" : "=v"(r) : "v"(lo), "v"(hi)); return r; }
typedef float f32x2 __attribute__((ext_vector_type(2)));
typedef unsigned u32x2 __attribute__((ext_vector_type(2)));
constexpr int NSS = 16;
__device__ __forceinline__ float ss_row_sum(const float* ss, int row) {
    const f32x4* p = (const f32x4*)(ss + (size_t)row * NSS);
    const f32x4 a = p[0], b = p[1], c = p[2], d = p[3];
    return ((a[0] + a[1]) + (a[2] + a[3])) + ((b[0] + b[1]) + (b[2] + b[3])) + ((c[0] + c[1]) + (c[2] + c[3])) + ((d[0] + d[1]) + (d[2] + d[3]));
}
struct EpiProj {
    static constexpr bool PERM = true, AFTER_DRAIN = false, MID = false; static constexpr int MID_T = -1;
    bf16_t* O; int ldc; const float* rs_tab;
    __device__ __forceinline__ void mid(f32x4 (&acc)[2][2][4][2], const Unit& u, int wr, int wc, int fr, int fq) const {}
    __device__ __forceinline__ void operator()(const f32x4 (&acc)[2][2][4][2], const Unit& u, int wr, int wc, int fr, int fq) const {
        const int row0 = u.pm * BM + wr * 64 + fr, col0 = u.pn * BM + wc * 32 + 8 * fq;
#pragma unroll
        for (int ai = 0; ai < 2; ++ai)
#pragma unroll
            for (int m = 0; m < 4; ++m) { const int row = row0 + ai * HALF + m * 16;
                const float rs = rs_tab[row];
                bf16_t* rowp = O + (size_t)row * ldc + col0;
#pragma unroll
                for (int bj = 0; bj < 2; ++bj) { const f32x4 v0 = acc[ai][bj][m][0] * rs, v1 = acc[ai][bj][m][1] * rs;
                    u32x4 w; w.x = cvt_pk_bf16(v0[0], v0[1]); w.y = cvt_pk_bf16(v0[2], v0[3]); w.z = cvt_pk_bf16(v1[0], v1[1]); w.w = cvt_pk_bf16(v1[2], v1[3]);
                    *(u32x4*)(rowp + bj * HALF) = w; }
                if (m & 1) asm volatile("" ::: "memory"); }
    }
};
struct EpiSwiglu {
    static constexpr bool PERM = true, AFTER_DRAIN = false, MID = false; static constexpr int MID_T = -1;
    bf16_t* O; int ldc; const float* rs_tab;
    __device__ __forceinline__ void mid(f32x4 (&acc)[2][2][4][2], const Unit& u, int wr, int wc, int fr, int fq) const {}
    __device__ __forceinline__ float act1(float g, float up, float rs) const { const float z = g * rs; return z * __builtin_amdgcn_rcpf(1.0f + __builtin_amdgcn_exp2f(z * -1.4426950408889634f)) * (up * rs); }
    __device__ __forceinline__ void operator()(const f32x4 (&acc)[2][2][4][2], const Unit& u, int wr, int wc, int fr, int fq) const {
        const int row0 = u.pm * BM + wr * 64 + fr, col0 = u.pn * HALF + wc * 32 + 8 * fq;
#pragma unroll
        for (int ai = 0; ai < 2; ++ai)
#pragma unroll
            for (int m = 0; m < 4; ++m) { const int row = row0 + ai * HALF + m * 16;
                const float rs = rs_tab[row];
                const f32x4 g0 = acc[ai][0][m][0], g1 = acc[ai][0][m][1], u0 = acc[ai][1][m][0], u1 = acc[ai][1][m][1];
                u32x4 w; w.x = cvt_pk_bf16(act1(g0[0], u0[0], rs), act1(g0[1], u0[1], rs)); w.y = cvt_pk_bf16(act1(g0[2], u0[2], rs), act1(g0[3], u0[3], rs));
                w.z = cvt_pk_bf16(act1(g1[0], u1[0], rs), act1(g1[1], u1[1], rs)); w.w = cvt_pk_bf16(act1(g1[2], u1[2], rs), act1(g1[3], u1[3], rs));
                *(u32x4*)(O + (size_t)row * ldc + col0) = w;
                if (m & 1) asm volatile("" ::: "memory"); }
    }
};
template <bool YSCALE> struct EpiRes {
    static constexpr bool PERM = false, AFTER_DRAIN = false, MID = YSCALE; static constexpr int MID_T = 8;
    const float* base; float* out; bf16_t* xb; float* ssout; const f32x2* ys;
    __device__ __forceinline__ void mid(f32x4 (&acc)[2][2][4][2], const Unit& u, int wr, int wc, int fr, int fq) const {
        if constexpr (YSCALE) {
            const int row0 = u.pm * BM + wr * 64 + fr;
#pragma unroll
            for (int ai = 0; ai < 2; ++ai)
#pragma unroll
                for (int m = 0; m < 4; ++m) { const float f = ys[row0 + ai * HALF + m * 16][0];
#pragma unroll
                    for (int bj = 0; bj < 2; ++bj)
#pragma unroll
                        for (int n = 0; n < 2; ++n) acc[ai][bj][m][n] *= f;
                    if (m & 1) asm volatile("" ::: "memory"); }
        }
    }
    __device__ __forceinline__ void operator()(const f32x4 (&acc)[2][2][4][2], const Unit& u, int wr, int wc, int fr, int fq) const {
        const int row0 = u.pm * BM + wr * 64 + fr, col0 = u.pn * BM + wc * 32 + 4 * fq;
#pragma unroll
        for (int ai = 0; ai < 2; ++ai)
#pragma unroll
            for (int m = 0; m < 4; ++m) { const int row = row0 + ai * HALF + m * 16; const size_t off = (size_t)row * 1024 + col0;
                float fs = 1.0f; if constexpr (YSCALE) fs = ys[row][1];
                float q = 0.f;
#pragma unroll
                for (int bj = 0; bj < 2; ++bj)
#pragma unroll
                    for (int n = 0; n < 2; ++n) { const f32x4 bs = *(const f32x4*)(base + off + bj * HALF + n * 16); const f32x4 o = bs + acc[ai][bj][m][n] * fs;
                        *(f32x4*)(out + off + bj * HALF + n * 16) = o;
                        u32x2 w; w.x = cvt_pk_bf16(o[0], o[1]); w.y = cvt_pk_bf16(o[2], o[3]); *(u32x2*)(xb + off + bj * HALF + n * 16) = w;
                        q += (o[0] * o[0] + o[1] * o[1]) + (o[2] * o[2] + o[3] * o[3]); }
                q += __shfl_xor(q, 16); q += __shfl_xor(q, 32);
                if (fq == 0) ssout[(size_t)row * NSS + u.pn * 4 + wc] = q;
                if (m & 1) asm volatile("" ::: "memory"); }
    }
};
template <class Epi, class Sched, bool ALIGN_EPI = false, bool SP2 = false>
__device__ __forceinline__ void gemm_phase(PG8_LAS unsigned char* lds, const Gemm g, const Sched& S, const Epi& E) {
    int tid_ = threadIdx.x; asm volatile("" : "+v"(tid_));
    const int tid = tid_, wid = __builtin_amdgcn_readfirstlane(tid >> 6), lane = tid & 63, wr = wid >> 2, wc = wid & 3, fr = lane & 15, fq = lane >> 4;
    const int K = g.K, nt = K / BK;
    unsigned voffA[2], voffB[2];
#pragma unroll
    for (int i = 0; i < 2; ++i) { int R, C; stage_rc(tid * 16 + i * 8192, R, C); const int Rb = Epi::PERM ? ((R & ~31) + perm32(R & 31)) : R;
        voffA[i] = (unsigned)(R * K + C) * 2u; voffB[i] = (unsigned)(Rb * K + C) * 2u; }
    const size_t kstep = (size_t)(BK * 2);
    const size_t hstep = (size_t)HALF * K * 2;
    const size_t tstep = 2 * hstep;
    const unsigned ldsw = (unsigned)wid * 1024u;
    const int aoff = lds_byte(wr * 64 + fr, fq * 8), boff = lds_byte(wc * 32 + fr, fq * 8);
#define PG8_SA(b, h) (((b) * 2 + (h)) * HTB)
#define PG8_SB(b, h) ((4 + (b) * 2 + (h)) * HTB)
#define PG8_STAGE(bufoff, gbase, voff) do { _Pragma("unroll") for (int _i = 0; _i < 2; ++_i) \
        __builtin_amdgcn_global_load_lds((const unsigned*)((const char*)(gbase) + (voff)[_i]), (PG8_LAS unsigned*)(lds + (bufoff) + ldsw + _i * 8192), 16, 0, 0); } while (0)
#define PG8_LDA(dst, b, h) do { _Pragma("unroll") for (int m = 0; m < 4; ++m) _Pragma("unroll") for (int k = 0; k < 2; ++k) dst[m][k] = *(const PG8_LAS bf16x8*)(lds + PG8_SA(b, h) + aoff + m * 2048 + k * 1024); } while (0)
#define PG8_LDB(dst, b, h) do { _Pragma("unroll") for (int n = 0; n < 2; ++n) _Pragma("unroll") for (int k = 0; k < 2; ++k) dst[n][k] = *(const PG8_LAS bf16x8*)(lds + PG8_SB(b, h) + boff + n * 2048 + k * 1024); } while (0)
#define PG8_MMA(ai, bj, At, Bt) do { __builtin_amdgcn_s_setprio(1); _Pragma("unroll") for (int m = 0; m < 4; ++m) _Pragma("unroll") for (int n = 0; n < 2; ++n) _Pragma("unroll") for (int k = 0; k < 2; ++k) \
        acc[ai][bj][m][n] = __builtin_amdgcn_mfma_f32_16x16x32_bf16(Bt[n][k], At[m][k], acc[ai][bj][m][n], 0, 0, 0); __builtin_amdgcn_s_setprio(0); } while (0)
#define PG8_WAIT_V(n) asm volatile("s_waitcnt vmcnt(" #n ")" ::: "memory")
#define PG8_WAIT_L(n) asm volatile("s_waitcnt lgkmcnt(" #n ")" ::: "memory")
#define PG8_BAR __builtin_amdgcn_s_barrier()
#define PG8_SCHED __builtin_amdgcn_sched_barrier(0)
    Unit cur, nxt; int ui = 0;
    if (!S.next(0, cur)) return;
    f32x4 acc[2][2][4][2];
#pragma unroll
    for (int a = 0; a < 2; ++a)
#pragma unroll
        for (int b = 0; b < 2; ++b)
#pragma unroll
            for (int m = 0; m < 4; ++m)
#pragma unroll
                for (int n = 0; n < 2; ++n) acc[a][b][m][n] = (f32x4){0.f, 0.f, 0.f, 0.f};
    bf16x8 At[4][2], B0[2][2], B1[2][2];
    const char* cA = (const char*)g.A + (size_t)cur.pm * tstep; const char* cB = (const char*)g.Bt + (size_t)cur.pn * tstep;
    S.a_ready(cur);
    if constexpr (SP2) {
        PG8_STAGE(PG8_SB(0, 0), cB, voffB); PG8_STAGE(PG8_SB(0, 1), cB + hstep, voffB); PG8_STAGE(PG8_SA(0, 0), cA, voffA); PG8_STAGE(PG8_SA(0, 1), cA + hstep, voffA);
        if (wr == 1) PG8_BAR;
        PG8_WAIT_V(2); PG8_BAR;
        PG8_STAGE(PG8_SB(1, 0), cB + kstep, voffB); PG8_STAGE(PG8_SA(1, 0), cA + kstep, voffA); PG8_STAGE(PG8_SB(1, 1), cB + hstep + kstep, voffB);
        PG8_WAIT_V(6); PG8_BAR;
    } else {
        PG8_STAGE(PG8_SB(0, 0), cB, voffB); PG8_STAGE(PG8_SA(0, 0), cA, voffA); PG8_STAGE(PG8_SB(0, 1), cB + hstep, voffB); PG8_STAGE(PG8_SA(0, 1), cA + hstep, voffA);
        if (wr == 1) PG8_BAR;
        PG8_WAIT_V(4); PG8_BAR;
        PG8_STAGE(PG8_SB(1, 0), cB + kstep, voffB); PG8_STAGE(PG8_SA(1, 0), cA + kstep, voffA); PG8_STAGE(PG8_SB(1, 1), cB + hstep + kstep, voffB);
        PG8_WAIT_V(6); PG8_BAR;
    }
    for (;;) {
        const bool has_next = S.next(ui + 1, nxt);
        const char* nA = has_next ? (const char*)g.A + (size_t)nxt.pm * tstep : cA; const char* nB = has_next ? (const char*)g.Bt + (size_t)nxt.pn * tstep : cB;
        for (int t = 0; t < nt; t += 2) {
            const bool last = (t == nt - 2);
            const char* a1 = cA + (size_t)(t + 1) * kstep;
            const char* a2 = last ? nA : cA + (size_t)(t + 2) * kstep; const char* b2 = last ? nB : cB + (size_t)(t + 2) * kstep;
            const char* a3 = a2 + kstep; const char* b3 = b2 + kstep;
            if (last && has_next) S.a_ready(nxt);
            if constexpr (Epi::MID) { if (t == Epi::MID_T) E.mid(acc, cur, wr, wc, fr, fq); }
            if constexpr (SP2) {
            PG8_LDB(B0, 0, 0); PG8_LDB(B1, 0, 1); PG8_SCHED; PG8_LDA(At, 0, 0); PG8_STAGE(PG8_SA(1, 1), a1 + hstep, voffA);
            PG8_WAIT_V(8); PG8_WAIT_L(0); PG8_BAR; PG8_MMA(0, 0, At, B0); PG8_MMA(0, 1, At, B1); PG8_BAR; PG8_SCHED;
            PG8_LDA(At, 0, 1); PG8_STAGE(PG8_SB(0, 0), b2, voffB); PG8_STAGE(PG8_SB(0, 1), b2 + hstep, voffB); PG8_STAGE(PG8_SA(0, 0), a2, voffA);
            PG8_WAIT_V(8); PG8_WAIT_L(0); PG8_BAR; PG8_MMA(1, 0, At, B0); PG8_MMA(1, 1, At, B1); PG8_BAR; PG8_SCHED;
            PG8_LDB(B0, 1, 0); PG8_LDB(B1, 1, 1); PG8_SCHED; PG8_LDA(At, 1, 0); PG8_STAGE(PG8_SA(0, 1), a2 + hstep, voffA);
            PG8_WAIT_V(8); PG8_WAIT_L(0); PG8_BAR; PG8_MMA(0, 0, At, B0); PG8_MMA(0, 1, At, B1); PG8_BAR; PG8_SCHED;
            PG8_LDA(At, 1, 1); PG8_STAGE(PG8_SB(1, 0), b3, voffB); PG8_STAGE(PG8_SB(1, 1), b3 + hstep, voffB); PG8_STAGE(PG8_SA(1, 0), a3, voffA);
            PG8_WAIT_V(8); PG8_WAIT_L(0); PG8_BAR; PG8_MMA(1, 0, At, B0); PG8_MMA(1, 1, At, B1); PG8_BAR; PG8_SCHED;
            } else {
            PG8_LDB(B0, 0, 0); PG8_SCHED; PG8_LDA(At, 0, 0); PG8_STAGE(PG8_SA(1, 1), a1 + hstep, voffA);
            PG8_WAIT_L(8); PG8_BAR; PG8_WAIT_L(0); PG8_MMA(0, 0, At, B0); PG8_BAR; PG8_SCHED;
            PG8_LDB(B1, 0, 1); PG8_STAGE(PG8_SB(0, 0), b2, voffB);
            PG8_BAR; PG8_WAIT_L(0); PG8_MMA(0, 1, At, B1); PG8_BAR;
            PG8_LDA(At, 0, 1); PG8_STAGE(PG8_SA(0, 0), a2, voffA);
            PG8_BAR; PG8_WAIT_L(0); PG8_MMA(1, 0, At, B0); PG8_BAR; PG8_SCHED;
            PG8_STAGE(PG8_SB(0, 1), b2 + hstep, voffB);
            PG8_WAIT_V(6); PG8_BAR; PG8_MMA(1, 1, At, B1); PG8_BAR;
            PG8_LDB(B0, 1, 0); PG8_SCHED; PG8_LDA(At, 1, 0); PG8_STAGE(PG8_SA(0, 1), a2 + hstep, voffA);
            PG8_WAIT_L(8); PG8_BAR; PG8_WAIT_L(0); PG8_MMA(0, 0, At, B0); PG8_BAR; PG8_SCHED;
            PG8_LDB(B1, 1, 1); PG8_STAGE(PG8_SB(1, 0), b3, voffB);
            PG8_BAR; PG8_WAIT_L(0); PG8_MMA(0, 1, At, B1); PG8_BAR;
            PG8_LDA(At, 1, 1); PG8_STAGE(PG8_SA(1, 0), a3, voffA);
            PG8_BAR; PG8_WAIT_L(0); PG8_MMA(1, 0, At, B0); PG8_BAR; PG8_SCHED;
            PG8_STAGE(PG8_SB(1, 1), b3 + hstep, voffB);
            PG8_WAIT_V(6); PG8_BAR; PG8_MMA(1, 1, At, B1); PG8_BAR;
            }
        }
        if constexpr (ALIGN_EPI) { if (wr == 0) PG8_BAR; }
        if constexpr (!Epi::AFTER_DRAIN) { E(acc, cur, wr, wc, fr, fq); S.done(cur); }
        if (!has_next) break;
#pragma unroll
        for (int a = 0; a < 2; ++a)
#pragma unroll
            for (int b = 0; b < 2; ++b)
#pragma unroll
                for (int m = 0; m < 4; ++m)
#pragma unroll
                    for (int n = 0; n < 2; ++n) acc[a][b][m][n] = (f32x4){0.f, 0.f, 0.f, 0.f};
        cur = nxt; cA = nA; cB = nB; ++ui;
        if constexpr (ALIGN_EPI) { if (wr == 1) PG8_BAR; }
    }
    PG8_WAIT_V(0);
    if constexpr (!ALIGN_EPI) { if (wr == 0) PG8_BAR; }
    PG8_BAR;
    if constexpr (Epi::AFTER_DRAIN) { E.fused(acc, cur, wr, wc, fr, fq, lds, wid, lane); S.done(cur); }
#undef PG8_SA
#undef PG8_SB
#undef PG8_STAGE
#undef PG8_LDA
#undef PG8_LDB
#undef PG8_MMA
#undef PG8_WAIT_V
#undef PG8_WAIT_L
#undef PG8_BAR
#undef PG8_SCHED
}
}

constexpr int NWAVES = 8;
constexpr int BATCH = 8, SEQ = 4096, D = 1024, DEPTH = 2, M = BATCH * SEQ, IN_COLS = 2304, FF = 2816, GU = 2 * FF;
constexpr float EPS = 1e-6f, LOG2E = 1.4426950408889634f, C2 = 0.125f * LOG2E;
constexpr int NPHASE = 12;
#ifndef MK_ONE_LAUNCH
#define MK_ONE_LAUNCH 0
#endif
constexpr size_t MiB = 1u << 20;
constexpr size_t WS_CTL = 0, CTL_ZERO_BYTES = 1 * MiB;
constexpr size_t WS_SS_MIX = 2 * MiB, WS_SSY = 4 * MiB, WS_SS_FFN = 6 * MiB;
constexpr size_t WS_RS = 1 * MiB;
constexpr size_t WS_W = 8 * MiB, W_LAYER = 23 * MiB, W_IN = 0, W_OUT = 9 * MiB / 2, W_GU = 13 * MiB / 2, W_DOWN = 35 * MiB / 2;
constexpr size_t WS_ATT = 56 * MiB;
constexpr size_t WS_XB = 96 * MiB, WS_PROJ = 160 * MiB, WS_Y = 304 * MiB, WS_ACT = 160 * MiB, WS_END = 368 * MiB;
constexpr int CW_BAR = 4096;
constexpr int RING_OFF = 0, RING_BYTES = 131072;
constexpr int LDSCTL_OFF = RING_BYTES, MISC_OFF = LDSCTL_OFF + 320;
constexpr int LDS_BYTES = 147456;
#define GAS __attribute__((address_space(1)))
#define LAS __attribute__((address_space(3)))
typedef unsigned short bf16;
typedef unsigned v4u __attribute__((ext_vector_type(4)));
typedef float f32x4 __attribute__((ext_vector_type(4)));
typedef short bf16x8 __attribute__((ext_vector_type(8)));
typedef GAS unsigned gu32;
typedef GAS unsigned long long gu64;
#define RLX_AGENT __ATOMIC_RELAXED, __HIP_MEMORY_SCOPE_AGENT
#define LDS_WAIT() asm volatile("s_waitcnt lgkmcnt(0)" ::: "memory")
#define VM_WAIT() asm volatile("s_waitcnt vmcnt(0)" ::: "memory")
__device__ __forceinline__ unsigned long long rt() { return __builtin_amdgcn_s_memrealtime(); }
__device__ __forceinline__ unsigned f2bf(float f) { unsigned u = __builtin_bit_cast(unsigned, f); return (u + 0x7fffu + ((u >> 16) & 1u)) >> 16; }
__device__ __forceinline__ unsigned pk2(float lo, float hi) { return f2bf(lo) | (f2bf(hi) << 16); }

#define XB_TMO      128
#define XB_XCNT(j)  (256  + 64 * (j))
#define XB_XSUB(j)  (1280 + 64 * (j))
#define XB_XGEN(j)  (2304 + 64 * (j))
#define XB_TOP      3328
#define XB_TOPGEN   3392
#define XCD_BAR_WORDS 3456
#define XB_SPIN_CAP (1u << 18)

__device__ __forceinline__ unsigned xb_ld(unsigned* p)              { return __hip_atomic_load(p, __ATOMIC_RELAXED, __HIP_MEMORY_SCOPE_AGENT); }
__device__ __forceinline__ unsigned xb_add(unsigned* p, unsigned v) { return __hip_atomic_fetch_add(p, v, __ATOMIC_RELAXED, __HIP_MEMORY_SCOPE_AGENT); }
__device__ __forceinline__ unsigned xb_xcc_id() { return (unsigned)__builtin_amdgcn_s_getreg((3 << 11) | 20) & 0xFu; }
#define XB_SPIN(cond, bar) do { unsigned _sp = 0; while (cond) { __builtin_amdgcn_s_sleep(1); \
    if ((++_sp & 255u) == 0u) { if (xb_ld(&(bar)[XB_TMO])) break; if (_sp > XB_SPIN_CAP) { atomicAdd(&(bar)[XB_TMO], 1u); break; } } } } while (0)

struct XcdBarrier {
    unsigned* bar; unsigned x;
    volatile LAS unsigned* st;
};

__device__ __forceinline__ XcdBarrier xcd_barrier_post(unsigned* bar, volatile LAS unsigned* st) {
    XcdBarrier b; b.bar = bar; b.x = xb_xcc_id(); b.st = st;
    if (threadIdx.x == 0) (void)xb_add(&bar[XB_XCNT(b.x)], 1u);
    return b;
}
__device__ __forceinline__ void xcd_barrier_complete(unsigned* bar, unsigned x, unsigned& nloc, unsigned& nx) {
    const unsigned G = gridDim.x * gridDim.y * gridDim.z;
    unsigned sum, cnt, mine, sp = 0u;
    for (;;) {
        sum = 0u; cnt = 0u; mine = 0u;
#pragma unroll
        for (unsigned j = 0; j < 16; ++j) { const unsigned c = xb_ld(&bar[XB_XCNT(j)]); sum += c; cnt += (c > 0u) ? 1u : 0u; mine = (j == x) ? c : mine; }
        if (sum == G) break;
        __builtin_amdgcn_s_sleep(1);
        if ((++sp & 255u) == 0u) { if (xb_ld(&bar[XB_TMO])) break; if (sp > XB_SPIN_CAP) { atomicAdd(&bar[XB_TMO], 1u); break; } }
    }
    nloc = mine > 0u ? mine : 1u; nx = cnt > 0u ? cnt : 1u;
}

__device__ __forceinline__ void xcd_barrier(const XcdBarrier& b) {
    asm volatile("s_waitcnt vmcnt(0)" ::: "memory");
    __syncthreads();
    if (threadIdx.x == 0) {
        unsigned* bar = b.bar;
        __builtin_amdgcn_s_waitcnt(0);
        unsigned nloc = b.st[0], nx = b.st[1];
        if (nloc == 0u) { xcd_barrier_complete(bar, b.x, nloc, nx); b.st[0] = nloc; b.st[1] = nx; }
        const unsigned old = xb_add(&bar[XB_XSUB(b.x)], 1u);
        const unsigned gen = old / nloc;
        if (old + 1u == (gen + 1u) * nloc) {
            __builtin_amdgcn_fence(__ATOMIC_RELEASE, "agent");
            asm volatile("s_waitcnt vmcnt(0)" ::: "memory");
            const unsigned og = xb_add(&bar[XB_TOP], 1u);
            const unsigned tg = og / nx;
            if (og + 1u == (tg + 1u) * nx) xb_add(&bar[XB_TOPGEN], 1u);
            else XB_SPIN(xb_ld(&bar[XB_TOPGEN]) == tg, bar);
            __builtin_amdgcn_fence(__ATOMIC_ACQUIRE, "agent");
            xb_add(&bar[XB_XGEN(b.x)], 1u);
            asm volatile("s_waitcnt vmcnt(0)" ::: "memory");
        } else {
            XB_SPIN(xb_ld(&bar[XB_XGEN(b.x)]) == gen, bar);
            __builtin_amdgcn_fence(__ATOMIC_ACQUIRE, "agent");
            asm volatile("s_waitcnt vmcnt(0)" ::: "memory");
        }
    }
    __syncthreads();
}

struct Frame {
    LAS unsigned char* lds;
    volatile LAS unsigned* MISC;
    gu32* ctl;
    int tid, lane, wave;
    int vcu, G;
};
__device__ __forceinline__ float wave_sum(float v) {
#pragma unroll
    for (int o = 1; o < 64; o <<= 1) v += __shfl_xor(v, o);
    return v;
}
__device__ __forceinline__ void p0_item(const float* W, int K, int N, bf16* WT, int out_row0, const float* gk, float nscale, LAS float* scr, int k0, int n0, int lane) {
#pragma unroll 8
    for (int i = 0; i < 32; ++i) { const int kk = 2 * i + (lane >> 5); const float g = gk ? gk[k0 + kk] : 1.0f; scr[kk * 33 + (lane & 31)] = W[(size_t)(k0 + kk) * N + n0 + (lane & 31)] * (g * nscale); }
    LDS_WAIT(); asm volatile("" ::: "memory");
    const int c = lane & 7;
#pragma unroll
    for (int j = 0; j < 4; ++j) { const int n = (lane >> 3) + 8 * j; const LAS float* s = scr + (8 * c) * 33 + n;
        v4u o; o.x = pk2(s[0 * 33], s[1 * 33]); o.y = pk2(s[2 * 33], s[3 * 33]); o.z = pk2(s[4 * 33], s[5 * 33]); o.w = pk2(s[6 * 33], s[7 * 33]);
        *(GAS v4u*)(WT + (size_t)(out_row0 + n) * K + k0 + 8 * c) = o; }
    LDS_WAIT(); asm volatile("" ::: "memory");
}
struct Ptrs {
    const float *x, *g_mix, *w_in, *g_out_dil, *g_out_win, *sink, *w_out, *g_ffn, *w_gate, *w_up, *w_down, *g_final;
    float* out; unsigned char* ws;
};
__device__ __forceinline__ void p0_prologue(Frame& F, const Ptrs& P) {
    LAS float* scr = (LAS float*)(F.lds + RING_OFF + F.wave * 16384);
    const int gw = F.vcu * NWAVES + F.wave, NGW = F.G * NWAVES;
    constexpr int I_IN = (D / 64) * (IN_COLS / 32), I_OUT = (D / 64) * (D / 32), I_G = (D / 64) * (FF / 32), I_D = (FF / 64) * (D / 32);
    constexpr int I_LAYER = I_IN + I_OUT + 2 * I_G + I_D;
    for (int it = gw; it < DEPTH * I_LAYER; it += NGW) {
        const int L = it / I_LAYER; int r = it % I_LAYER;
        bf16* wl = (bf16*)(P.ws + WS_W + (size_t)L * W_LAYER);
        if (r < I_IN) { const int nblk = IN_COLS / 32, kb = r / nblk, nb = r % nblk, n0 = 32 * nb; const bool isq = (n0 < 512) || (n0 >= 1536 && n0 < 2048);
            p0_item(P.w_in + (size_t)L * D * IN_COLS, D, IN_COLS, (bf16*)((unsigned char*)wl + W_IN), n0, P.g_mix + L * D, isq ? C2 : 1.0f, scr, 64 * kb, n0, F.lane); continue; } r -= I_IN;
        if (r < I_OUT) { const int nblk = D / 32, kb = r / nblk, nb = r % nblk, n0 = 32 * nb, k0 = 64 * kb;
            const float* gk = (k0 < 512) ? (P.g_out_dil + L * 512) : (P.g_out_win + L * 512 - 512);
            p0_item(P.w_out + (size_t)L * D * D, D, D, (bf16*)((unsigned char*)wl + W_OUT), n0, gk, 1.0f, scr, k0, n0, F.lane); continue; } r -= I_OUT;
        if (r < 2 * I_G) { const bool up = r >= I_G; if (up) r -= I_G; const int nblk = FF / 32, kb = r / nblk, nb = r % nblk, n0 = 32 * nb;
            const int orow = 256 * (n0 / 128) + (up ? 128 : 0) + (n0 % 128);
            p0_item((up ? P.w_up : P.w_gate) + (size_t)L * D * FF, D, FF, (bf16*)((unsigned char*)wl + W_GU), orow, P.g_ffn + L * D, 1.0f, scr, 64 * kb, n0, F.lane); continue; } r -= 2 * I_G;
        { const int nblk = D / 32, kb = r / nblk, nb = r % nblk, n0 = 32 * nb;
            p0_item(P.w_down + (size_t)L * FF * D, FF, D, (bf16*)((unsigned char*)wl + W_DOWN), n0, nullptr, 1.0f, scr, 64 * kb, n0, F.lane); }
    }
    bf16* XB = (bf16*)(P.ws + WS_XB); float* ss = (float*)(P.ws + WS_SS_MIX);
    for (int m = gw; m < M; m += NGW) {
        const GAS f32x4* xr = (const GAS f32x4*)(P.x + (size_t)m * D) + F.lane;
        f32x4 v[4]; float s = 0.f;
#pragma unroll
        for (int j = 0; j < 4; ++j) { v[j] = xr[64 * j]; s += (v[j].x * v[j].x + v[j].y * v[j].y) + (v[j].z * v[j].z + v[j].w * v[j].w); }
        s = wave_sum(s);
        GAS unsigned long long* o8 = (GAS unsigned long long*)(XB + (size_t)m * D) + F.lane;
#pragma unroll
        for (int j = 0; j < 4; ++j) o8[64 * j] = (unsigned long long)pk2(v[j].x, v[j].y) | ((unsigned long long)pk2(v[j].z, v[j].w) << 32);
        if (F.lane < 16) ss[(size_t)m * 16 + F.lane] = (F.lane == 0) ? s : 0.f;
    }
}
__device__ __forceinline__ void final_norm(Frame& F, const Ptrs& P) {
    const int gw = F.vcu * NWAVES + F.wave, NGW = F.G * NWAVES; const float* ss = (const float*)(P.ws + WS_SS_MIX);
    f32x4 g[4];
#pragma unroll
    for (int j = 0; j < 4; ++j) g[j] = ((const GAS f32x4*)P.g_final)[F.lane + 64 * j];
    for (int m = gw; m < M; m += NGW) {
        GAS f32x4* xr = (GAS f32x4*)(P.out + (size_t)m * D) + F.lane;
        const float rs = __builtin_amdgcn_rsqf(pg8::ss_row_sum(ss, m) * (1.0f / 1024.0f) + EPS);
#pragma unroll
        for (int j = 0; j < 4; ++j) { f32x4 v = xr[64 * j]; v = v * rs * g[j]; xr[64 * j] = v; }
    }
}
__device__ __forceinline__ void attn_naive(Frame& F, const bf16* proj, const float* sink, bf16* Y, float* SSY) {
    for (int gid = F.vcu * 512 + F.tid; gid < M * 16; gid += F.G * 512) {
        const int h16 = gid / M, tok = gid % M, b = tok / SEQ, t = tok % SEQ;
        const bool dg = h16 < 8; const int h = dg ? h16 : h16 - 8;
        const int qoff = dg ? h * 64 : 1536 + h * 64, koff = dg ? 512 + h * 64 : 2048 + (h >> 2) * 64, voff = dg ? 1024 + h * 64 : 2176 + (h >> 2) * 64;
        const float slope2 = exp2f(-0.5f * (float)((dg ? 8 + h : h) + 1)) * LOG2E;
        float q[64], o[64];
        const bf16* qp = proj + (size_t)tok * IN_COLS + qoff;
#pragma unroll
        for (int d = 0; d < 64; d += 2) { const unsigned raw = *(const unsigned*)(qp + d); q[d] = __uint_as_float(raw << 16); q[d + 1] = __uint_as_float(raw & 0xffff0000u); o[d] = 0.f; o[d + 1] = 0.f; }
        float m, l;
        if (dg) { m = -1e30f; l = 0.f; } else { m = sink[h] * LOG2E; l = 1.f; }
        const int npat = dg ? 3 : 1;
        for (int p = 0; p < npat; ++p) {
            const int dil = dg ? (p == 0 ? 1 : (p == 1 ? 4 : 16)) : 1, side = dg ? 64 : 128;
            for (int j = -side; j <= side; ++j) {
                const int t2 = t + dil * j;
                if (t2 < 0 || t2 >= SEQ) continue;
                const bf16* kp = proj + (size_t)(b * SEQ + t2) * IN_COLS + koff;
                float s = 0.f;
#pragma unroll
                for (int d = 0; d < 64; d += 2) { const unsigned raw = *(const unsigned*)(kp + d); s += q[d] * __uint_as_float(raw << 16) + q[d + 1] * __uint_as_float(raw & 0xffff0000u); }
                s -= slope2 * (float)((j < 0 ? -j : j) * dil);
                const float mn = fmaxf(m, s), a = __builtin_amdgcn_exp2f(m - mn), pz = __builtin_amdgcn_exp2f(s - mn);
                l = l * a + pz; m = mn;
                const bf16* vp = proj + (size_t)(b * SEQ + t2) * IN_COLS + voff;
#pragma unroll
                for (int d = 0; d < 64; d += 2) { const unsigned raw = *(const unsigned*)(vp + d); o[d] = o[d] * a + pz * __uint_as_float(raw << 16); o[d + 1] = o[d + 1] * a + pz * __uint_as_float(raw & 0xffff0000u); }
            }
        }
        const float inv = 1.f / l; float sq = 0.f;
        bf16* yp = Y + (size_t)tok * D + h16 * 64;
#pragma unroll
        for (int d = 0; d < 64; d += 2) { const float a = o[d] * inv, c = o[d + 1] * inv; sq += a * a + c * c; *(unsigned*)(yp + d) = pk2(a, c); }
        SSY[(size_t)tok * 16 + h16] = sq;
    }
}

template <int MODE> __device__ __forceinline__ void rs_prepass(const pg8::StaticOrder& S, const float* ss, float* tab, int tid) {
    pg8::Unit u;
    for (int i = 0; S.next(i, u); ++i)
        for (int r = tid; r < 256; r += NWAVES * 64) { const int row = u.pm * 256 + r;
            const f32x4* p = (const f32x4*)(ss + (size_t)row * 16); const f32x4 a = p[0], b = p[1], c = p[2], d = p[3];
            const float s0 = ((a[0] + a[1]) + (a[2] + a[3])) + ((b[0] + b[1]) + (b[2] + b[3])), s1 = ((c[0] + c[1]) + (c[2] + c[3])) + ((d[0] + d[1]) + (d[2] + d[3]));
            if (MODE == 0) tab[row] = __builtin_amdgcn_rsqf((s0 + s1) * (1.0f / 1024.0f) + EPS);
            else { const float ra = __builtin_amdgcn_rsqf(s0 * (1.0f / 512.0f) + EPS), rb = __builtin_amdgcn_rsqf(s1 * (1.0f / 512.0f) + EPS); pg8::f32x2 v; v[0] = ra * __builtin_amdgcn_rcpf(rb); v[1] = rb; ((pg8::f32x2*)tab)[row] = v; } }
    __syncthreads();
}

struct Args { const float* in[12]; float* out; unsigned char* ws; int ph_lo, ph_hi, li, pad; };
__global__ void __launch_bounds__(NWAVES * 64, 2) mk_fwd(Args args) {
    extern __shared__ __attribute__((aligned(16))) unsigned char lds[];
    Frame F;
    F.lds = (LAS unsigned char*)lds;
    F.MISC = (volatile LAS unsigned*)(F.lds + MISC_OFF);
    F.tid = threadIdx.x; F.lane = F.tid & 63; F.wave = __builtin_amdgcn_readfirstlane(F.tid >> 6);
    F.G = gridDim.x; { const int bx = blockIdx.x; F.vcu = (F.G % 8 == 0) ? (bx % 8) * (F.G / 8) + bx / 8 : bx; }
    unsigned char* ws = args.ws;
    F.ctl = (gu32*)(ws + WS_CTL);
    Ptrs P; P.x = args.in[0]; P.g_mix = args.in[1]; P.w_in = args.in[2]; P.g_out_dil = args.in[3]; P.g_out_win = args.in[4]; P.sink = args.in[5]; P.w_out = args.in[6];
    P.g_ffn = args.in[7]; P.w_gate = args.in[8]; P.w_up = args.in[9]; P.w_down = args.in[10]; P.g_final = args.in[11]; P.out = args.out; P.ws = ws;
    for (int u = F.tid; u < (LDS_BYTES - LDSCTL_OFF) / 4; u += NWAVES * 64) ((LAS unsigned*)(F.lds + LDSCTL_OFF))[u] = 0u;
    __syncthreads();
    XcdBarrier bar; bar.bar = (unsigned*)(F.ctl + CW_BAR); bar.x = 0; bar.st = nullptr;
    if (MK_ONE_LAUNCH) bar = xcd_barrier_post((unsigned*)(F.ctl + CW_BAR), F.MISC + 8);
    const int lo = args.ph_lo, hi = args.ph_hi;
#define IN(k) (lo <= (k) && (k) < hi)
#define SEAM(k) do { if (MK_ONE_LAUNCH && IN(k) && IN((k) + 1)) xcd_barrier(bar); } while (0)
    bf16* XB = (bf16*)(ws + WS_XB); bf16* PROJ = (bf16*)(ws + WS_PROJ); bf16* Y = (bf16*)(ws + WS_Y); bf16* ACT = (bf16*)(ws + WS_ACT);
    float* SS_MIX = (float*)(ws + WS_SS_MIX); float* SSY = (float*)(ws + WS_SSY); float* SS_FFN = (float*)(ws + WS_SS_FFN); float* RS = (float*)(ws + WS_RS);

    if (IN(0)) { p0_prologue(F, P); } SEAM(0);
    for (int L = 0; L < DEPTH; ++L) {
        const int pb = 1 + 5 * L;
        const unsigned char* wl = ws + WS_W + (size_t)L * W_LAYER;
        if (IN(pb)) {
            pg8::Gemm g{XB, (const bf16*)(wl + W_IN), M, IN_COLS, D}; pg8::StaticOrder S; S.init(M, IN_COLS, F.G, (int)blockIdx.x);
            rs_prepass<0>(S, SS_MIX, RS, F.tid); pg8::EpiProj E{PROJ, IN_COLS, RS};
            pg8::gemm_phase<pg8::EpiProj, pg8::StaticOrder, true, true>(F.lds + RING_OFF, g, S, E);
        } SEAM(pb);
        if (IN(pb + 1)) { attn_naive(F, PROJ, P.sink + L * 8, Y, SSY); } SEAM(pb + 1);
        if (IN(pb + 2)) {
            pg8::Gemm g{Y, (const bf16*)(wl + W_OUT), M, D, D}; pg8::StaticOrder S; S.init(M, D, F.G, (int)blockIdx.x);
            rs_prepass<1>(S, SSY, RS, F.tid); pg8::EpiRes<true> E{L == 0 ? P.x : P.out, P.out, XB, SS_FFN, (const pg8::f32x2*)RS};
            pg8::gemm_phase<pg8::EpiRes<true>, pg8::StaticOrder, true, true>(F.lds + RING_OFF, g, S, E);
        } SEAM(pb + 2);
        if (IN(pb + 3)) {
            pg8::Gemm g{XB, (const bf16*)(wl + W_GU), M, GU, D}; pg8::StaticOrder S; S.init(M, GU, F.G, (int)blockIdx.x);
            rs_prepass<0>(S, SS_FFN, RS, F.tid); pg8::EpiSwiglu E{ACT, FF, RS};
            pg8::gemm_phase<pg8::EpiSwiglu, pg8::StaticOrder, true, true>(F.lds + RING_OFF, g, S, E);
        } SEAM(pb + 3);
        if (IN(pb + 4)) {
            pg8::Gemm g{ACT, (const bf16*)(wl + W_DOWN), M, D, FF}; pg8::StaticOrder S; S.init(M, D, F.G, (int)blockIdx.x);
            pg8::EpiRes<false> E{P.out, P.out, XB, SS_MIX, nullptr};
            pg8::gemm_phase<pg8::EpiRes<false>, pg8::StaticOrder, true, true>(F.lds + RING_OFF, g, S, E);
        } SEAM(pb + 4);
    }
    if (IN(11)) { final_norm(F, P); }
#undef IN
#undef SEAM
}

extern "C" void kernel_launch(void* const* d_in, const int* in_sizes, int n_in, void* d_out, int out_size, void* d_ws, size_t ws_size, hipStream_t stream) {
    static int grid = 0;
    if (grid == 0) {
        if (n_in != 12 || in_sizes[0] != M * D || out_size != M * D || ws_size < WS_END) { fprintf(stderr, "kernel_launch: unexpected sizes (n_in %d, in0 %d, out %d, ws %zu); nothing launched\n", n_in, n_in > 0 ? in_sizes[0] : -1, out_size, ws_size); grid = -1; return; }
        int dev = 0, cus = 0, per_cu = 0;
        if (hipGetDevice(&dev) != hipSuccess || hipDeviceGetAttribute(&cus, hipDeviceAttributeMultiprocessorCount, dev) != hipSuccess) { fprintf(stderr, "kernel_launch: device query failed\n"); grid = -1; return; }
        if (hipFuncSetAttribute((const void*)mk_fwd, hipFuncAttributeMaxDynamicSharedMemorySize, LDS_BYTES) != hipSuccess) { fprintf(stderr, "kernel_launch: hipFuncSetAttribute failed\n"); grid = -1; return; }
        if (hipOccupancyMaxActiveBlocksPerMultiprocessor(&per_cu, (const void*)mk_fwd, NWAVES * 64, LDS_BYTES) != hipSuccess || per_cu < 1) { fprintf(stderr, "kernel_launch: occupancy query reports %d workgroups per CU\n", per_cu); (void)hipGetLastError(); grid = -1; return; }
        grid = cus;
    }
    if (grid < 0) return;
    if (hipMemsetAsync((char*)d_ws + WS_CTL, 0, CTL_ZERO_BYTES, stream) != hipSuccess) { fprintf(stderr, "kernel_launch: memset failed\n"); return; }
    Args a{};
    for (int i = 0; i < 12; ++i) a.in[i] = (const float*)d_in[i];
    a.out = (float*)d_out; a.ws = (unsigned char*)d_ws;
#if MK_ONE_LAUNCH
    a.ph_lo = 0; a.ph_hi = NPHASE; a.li = 0;
    hipLaunchKernelGGL(mk_fwd, dim3(grid), dim3(NWAVES * 64), LDS_BYTES, stream, a);
#else
    for (int p = 0; p < NPHASE; ++p) { a.ph_lo = p; a.ph_hi = p + 1; a.li = p; hipLaunchKernelGGL(mk_fwd, dim3(grid), dim3(NWAVES * 64), LDS_BYTES, stream, a); }
#endif
    const hipError_t le = hipPeekAtLastError();
    if (le != hipSuccess) fprintf(stderr, "kernel_launch: launch failed: %s\n", hipGetErrorName(le));
}
```

```cpp
#define MK_ONE_LAUNCH 1
#include <hip/hip_runtime.h>
#include <cstdio>
#include <cstdint>
namespace pg8 {
#define PG8_LAS __attribute__((address_space(3)))
typedef unsigned short bf16_t;
typedef short bf16x8 __attribute__((ext_vector_type(8)));
typedef float f32x4 __attribute__((ext_vector_type(4)));
typedef unsigned u32x4 __attribute__((ext_vector_type(4)));
constexpr int BM = 256, BK = 64, HALF = 128, HTB = HALF * BK * 2  , STAGE_BYTES = 8 * HTB, NXCD = 8, WGM = 8;

__host__ __device__ __forceinline__ int lds_byte(int r, int c) { const int st = (r >> 4) * 2 + (c >> 5), rr = r & 15, cc = c & 31, ob = rr * 64 + cc * 2; return st * 1024 + (ob ^ (((ob >> 9) & 1) << 5)); }
__host__ __device__ __forceinline__ void stage_rc(int b, int& R, int& C) { const int st = b / 1024, sb = b % 1024, swz = sb ^ (((sb >> 9) & 1) << 5); R = (st >> 1) * 16 + swz / 64; C = (st & 1) * 32 + (swz % 64) / 2; }
__host__ __device__ __forceinline__ int perm32(int rho) { const int n = rho >> 4, i = rho & 15; return 8 * (i >> 2) + 4 * n + (i & 3); }

struct Unit { int pm, pn; };
struct Gemm { const bf16_t* A; const bf16_t* Bt; int M, N, K; };

struct StaticOrder {
    int nM, nN, nwg, G, c;
    __host__ __device__ void init(int M, int N, int G_, int c_) { nM = M / BM; nN = N / BM; nwg = nM * nN; G = G_; c = c_; }
    __host__ __device__ bool next(int i, Unit& u) const {
        const long L = (long)i * G + c; if (L >= nwg) return false;
        int wgid = (int)L; { const int q = nwg / NXCD, r = nwg % NXCD, xcd = wgid % NXCD, off = wgid / NXCD; wgid = (xcd < r ? xcd * (q + 1) : r * (q + 1) + (xcd - r) * q) + off; }
        const int nig = WGM * nN, gid = wgid / nig, fm = gid * WGM, gsz = (nM - fm) < WGM ? (nM - fm) : WGM;
        u.pm = fm + ((wgid % nig) % gsz); u.pn = (wgid % nig) / gsz; return true;
    }
    __device__ __forceinline__ void a_ready(const Unit&) const {}
    __device__ __forceinline__ void done(const Unit&) const {}
};


__device__ __forceinline__ unsigned cvt_pk_bf16(float lo, float hi) { unsigned r; asm volatile("v_cvt_pk_bf16_f32 %0, %1, %2" : "=v"(r) : "v"(lo), "v"(hi)); return r; }
typedef float f32x2 __attribute__((ext_vector_type(2)));
typedef unsigned u32x2 __attribute__((ext_vector_type(2)));
constexpr int NSS = 16;
__device__ __forceinline__ float ss_row_sum(const float* ss, int row) {
    const f32x4* p = (const f32x4*)(ss + (size_t)row * NSS);
    const f32x4 a = p[0], b = p[1], c = p[2], d = p[3];
    return ((a[0] + a[1]) + (a[2] + a[3])) + ((b[0] + b[1]) + (b[2] + b[3])) + ((c[0] + c[1]) + (c[2] + c[3])) + ((d[0] + d[1]) + (d[2] + d[3]));
}
struct EpiProj {
    static constexpr bool PERM = true, AFTER_DRAIN = false, MID = false; static constexpr int MID_T = -1;
    bf16_t* O; int ldc; const float* rs_tab;
    __device__ __forceinline__ void mid(f32x4 (&acc)[2][2][4][2], const Unit& u, int wr, int wc, int fr, int fq) const {}
    __device__ __forceinline__ void operator()(const f32x4 (&acc)[2][2][4][2], const Unit& u, int wr, int wc, int fr, int fq) const {
        const int row0 = u.pm * BM + wr * 64 + fr, col0 = u.pn * BM + wc * 32 + 8 * fq;
#pragma unroll
        for (int ai = 0; ai < 2; ++ai)
#pragma unroll
            for (int m = 0; m < 4; ++m) { const int row = row0 + ai * HALF + m * 16;
                const float rs = rs_tab[row];
                bf16_t* rowp = O + (size_t)row * ldc + col0;
#pragma unroll
                for (int bj = 0; bj < 2; ++bj) { const f32x4 v0 = acc[ai][bj][m][0] * rs, v1 = acc[ai][bj][m][1] * rs;
                    u32x4 w; w.x = cvt_pk_bf16(v0[0], v0[1]); w.y = cvt_pk_bf16(v0[2], v0[3]); w.z = cvt_pk_bf16(v1[0], v1[1]); w.w = cvt_pk_bf16(v1[2], v1[3]);
                    *(u32x4*)(rowp + bj * HALF) = w; }
                if (m & 1) asm volatile("" ::: "memory"); }
    }
};
struct EpiSwiglu {
    static constexpr bool PERM = true, AFTER_DRAIN = false, MID = false; static constexpr int MID_T = -1;
    bf16_t* O; int ldc; const float* rs_tab;
    __device__ __forceinline__ void mid(f32x4 (&acc)[2][2][4][2], const Unit& u, int wr, int wc, int fr, int fq) const {}
    __device__ __forceinline__ float act1(float g, float up, float rs) const { const float z = g * rs; return z * __builtin_amdgcn_rcpf(1.0f + __builtin_amdgcn_exp2f(z * -1.4426950408889634f)) * (up * rs); }
    __device__ __forceinline__ void operator()(const f32x4 (&acc)[2][2][4][2], const Unit& u, int wr, int wc, int fr, int fq) const {
        const int row0 = u.pm * BM + wr * 64 + fr, col0 = u.pn * HALF + wc * 32 + 8 * fq;
#pragma unroll
        for (int ai = 0; ai < 2; ++ai)
#pragma unroll
            for (int m = 0; m < 4; ++m) { const int row = row0 + ai * HALF + m * 16;
                const float rs = rs_tab[row];
                const f32x4 g0 = acc[ai][0][m][0], g1 = acc[ai][0][m][1], u0 = acc[ai][1][m][0], u1 = acc[ai][1][m][1];
                u32x4 w; w.x = cvt_pk_bf16(act1(g0[0], u0[0], rs), act1(g0[1], u0[1], rs)); w.y = cvt_pk_bf16(act1(g0[2], u0[2], rs), act1(g0[3], u0[3], rs));
                w.z = cvt_pk_bf16(act1(g1[0], u1[0], rs), act1(g1[1], u1[1], rs)); w.w = cvt_pk_bf16(act1(g1[2], u1[2], rs), act1(g1[3], u1[3], rs));
                *(u32x4*)(O + (size_t)row * ldc + col0) = w;
                if (m & 1) asm volatile("" ::: "memory"); }
    }
};
template <bool YSCALE> struct EpiRes {
    static constexpr bool PERM = false, AFTER_DRAIN = false, MID = YSCALE; static constexpr int MID_T = 8;
    const float* base; float* out; bf16_t* xb; float* ssout; const f32x2* ys;
    __device__ __forceinline__ void mid(f32x4 (&acc)[2][2][4][2], const Unit& u, int wr, int wc, int fr, int fq) const {
        if constexpr (YSCALE) {
            const int row0 = u.pm * BM + wr * 64 + fr;
#pragma unroll
            for (int ai = 0; ai < 2; ++ai)
#pragma unroll
                for (int m = 0; m < 4; ++m) { const float f = ys[row0 + ai * HALF + m * 16][0];
#pragma unroll
                    for (int bj = 0; bj < 2; ++bj)
#pragma unroll
                        for (int n = 0; n < 2; ++n) acc[ai][bj][m][n] *= f;
                    if (m & 1) asm volatile("" ::: "memory"); }
        }
    }
    __device__ __forceinline__ void operator()(const f32x4 (&acc)[2][2][4][2], const Unit& u, int wr, int wc, int fr, int fq) const {
        const int row0 = u.pm * BM + wr * 64 + fr, col0 = u.pn * BM + wc * 32 + 4 * fq;
#pragma unroll
        for (int ai = 0; ai < 2; ++ai)
#pragma unroll
            for (int m = 0; m < 4; ++m) { const int row = row0 + ai * HALF + m * 16; const size_t off = (size_t)row * 1024 + col0;
                float fs = 1.0f; if constexpr (YSCALE) fs = ys[row][1];
                float q = 0.f;
#pragma unroll
                for (int bj = 0; bj < 2; ++bj)
#pragma unroll
                    for (int n = 0; n < 2; ++n) { const f32x4 bs = *(const f32x4*)(base + off + bj * HALF + n * 16); const f32x4 o = bs + acc[ai][bj][m][n] * fs;
                        *(f32x4*)(out + off + bj * HALF + n * 16) = o;
                        u32x2 w; w.x = cvt_pk_bf16(o[0], o[1]); w.y = cvt_pk_bf16(o[2], o[3]); *(u32x2*)(xb + off + bj * HALF + n * 16) = w;
                        q += (o[0] * o[0] + o[1] * o[1]) + (o[2] * o[2] + o[3] * o[3]); }
                q += __shfl_xor(q, 16); q += __shfl_xor(q, 32);
                if (fq == 0) ssout[(size_t)row * NSS + u.pn * 4 + wc] = q;
                if (m & 1) asm volatile("" ::: "memory"); }
    }
};
template <class Epi, class Sched, bool ALIGN_EPI = false, bool SP2 = false>
__device__ __forceinline__ void gemm_phase(PG8_LAS unsigned char* lds, const Gemm g, const Sched& S, const Epi& E) {
    int tid_ = threadIdx.x; asm volatile("" : "+v"(tid_));
    const int tid = tid_, wid = __builtin_amdgcn_readfirstlane(tid >> 6), lane = tid & 63, wr = wid >> 2, wc = wid & 3, fr = lane & 15, fq = lane >> 4;
    const int K = g.K, nt = K / BK;
    unsigned voffA[2], voffB[2];
#pragma unroll
    for (int i = 0; i < 2; ++i) { int R, C; stage_rc(tid * 16 + i * 8192, R, C); const int Rb = Epi::PERM ? ((R & ~31) + perm32(R & 31)) : R;
        voffA[i] = (unsigned)(R * K + C) * 2u; voffB[i] = (unsigned)(Rb * K + C) * 2u; }
    const size_t kstep = (size_t)(BK * 2);
    const size_t hstep = (size_t)HALF * K * 2;
    const size_t tstep = 2 * hstep;
    const unsigned ldsw = (unsigned)wid * 1024u;
    const int aoff = lds_byte(wr * 64 + fr, fq * 8), boff = lds_byte(wc * 32 + fr, fq * 8);
#define PG8_SA(b, h) (((b) * 2 + (h)) * HTB)
#define PG8_SB(b, h) ((4 + (b) * 2 + (h)) * HTB)
#define PG8_STAGE(bufoff, gbase, voff) do { _Pragma("unroll") for (int _i = 0; _i < 2; ++_i) \
        __builtin_amdgcn_global_load_lds((const unsigned*)((const char*)(gbase) + (voff)[_i]), (PG8_LAS unsigned*)(lds + (bufoff) + ldsw + _i * 8192), 16, 0, 0); } while (0)
#define PG8_LDA(dst, b, h) do { _Pragma("unroll") for (int m = 0; m < 4; ++m) _Pragma("unroll") for (int k = 0; k < 2; ++k) dst[m][k] = *(const PG8_LAS bf16x8*)(lds + PG8_SA(b, h) + aoff + m * 2048 + k * 1024); } while (0)
#define PG8_LDB(dst, b, h) do { _Pragma("unroll") for (int n = 0; n < 2; ++n) _Pragma("unroll") for (int k = 0; k < 2; ++k) dst[n][k] = *(const PG8_LAS bf16x8*)(lds + PG8_SB(b, h) + boff + n * 2048 + k * 1024); } while (0)
#define PG8_MMA(ai, bj, At, Bt) do { __builtin_amdgcn_s_setprio(1); _Pragma("unroll") for (int m = 0; m < 4; ++m) _Pragma("unroll") for (int n = 0; n < 2; ++n) _Pragma("unroll") for (int k = 0; k < 2; ++k) \
        acc[ai][bj][m][n] = __builtin_amdgcn_mfma_f32_16x16x32_bf16(Bt[n][k], At[m][k], acc[ai][bj][m][n], 0, 0, 0); __builtin_amdgcn_s_setprio(0); } while (0)
#define PG8_WAIT_V(n) asm volatile("s_waitcnt vmcnt(" #n ")" ::: "memory")
#define PG8_WAIT_L(n) asm volatile("s_waitcnt lgkmcnt(" #n ")" ::: "memory")
#define PG8_BAR __builtin_amdgcn_s_barrier()
#define PG8_SCHED __builtin_amdgcn_sched_barrier(0)
    Unit cur, nxt; int ui = 0;
    if (!S.next(0, cur)) return;
    f32x4 acc[2][2][4][2];
#pragma unroll
    for (int a = 0; a < 2; ++a)
#pragma unroll
        for (int b = 0; b < 2; ++b)
#pragma unroll
            for (int m = 0; m < 4; ++m)
#pragma unroll
                for (int n = 0; n < 2; ++n) acc[a][b][m][n] = (f32x4){0.f, 0.f, 0.f, 0.f};
    bf16x8 At[4][2], B0[2][2], B1[2][2];
    const char* cA = (const char*)g.A + (size_t)cur.pm * tstep; const char* cB = (const char*)g.Bt + (size_t)cur.pn * tstep;
    S.a_ready(cur);
    if constexpr (SP2) {
        PG8_STAGE(PG8_SB(0, 0), cB, voffB); PG8_STAGE(PG8_SB(0, 1), cB + hstep, voffB); PG8_STAGE(PG8_SA(0, 0), cA, voffA); PG8_STAGE(PG8_SA(0, 1), cA + hstep, voffA);
        if (wr == 1) PG8_BAR;
        PG8_WAIT_V(2); PG8_BAR;
        PG8_STAGE(PG8_SB(1, 0), cB + kstep, voffB); PG8_STAGE(PG8_SA(1, 0), cA + kstep, voffA); PG8_STAGE(PG8_SB(1, 1), cB + hstep + kstep, voffB);
        PG8_WAIT_V(6); PG8_BAR;
    } else {
        PG8_STAGE(PG8_SB(0, 0), cB, voffB); PG8_STAGE(PG8_SA(0, 0), cA, voffA); PG8_STAGE(PG8_SB(0, 1), cB + hstep, voffB); PG8_STAGE(PG8_SA(0, 1), cA + hstep, voffA);
        if (wr == 1) PG8_BAR;
        PG8_WAIT_V(4); PG8_BAR;
        PG8_STAGE(PG8_SB(1, 0), cB + kstep, voffB); PG8_STAGE(PG8_SA(1, 0), cA + kstep, voffA); PG8_STAGE(PG8_SB(1, 1), cB + hstep + kstep, voffB);
        PG8_WAIT_V(6); PG8_BAR;
    }
    for (;;) {
        const bool has_next = S.next(ui + 1, nxt);
        const char* nA = has_next ? (const char*)g.A + (size_t)nxt.pm * tstep : cA; const char* nB = has_next ? (const char*)g.Bt + (size_t)nxt.pn * tstep : cB;
        for (int t = 0; t < nt; t += 2) {
            const bool last = (t == nt - 2);
            const char* a1 = cA + (size_t)(t + 1) * kstep;
            const char* a2 = last ? nA : cA + (size_t)(t + 2) * kstep; const char* b2 = last ? nB : cB + (size_t)(t + 2) * kstep;
            const char* a3 = a2 + kstep; const char* b3 = b2 + kstep;
            if (last && has_next) S.a_ready(nxt);
            if constexpr (Epi::MID) { if (t == Epi::MID_T) E.mid(acc, cur, wr, wc, fr, fq); }
            if constexpr (SP2) {
            PG8_LDB(B0, 0, 0); PG8_LDB(B1, 0, 1); PG8_SCHED; PG8_LDA(At, 0, 0); PG8_STAGE(PG8_SA(1, 1), a1 + hstep, voffA);
            PG8_WAIT_V(8); PG8_WAIT_L(0); PG8_BAR; PG8_MMA(0, 0, At, B0); PG8_MMA(0, 1, At, B1); PG8_BAR; PG8_SCHED;
            PG8_LDA(At, 0, 1); PG8_STAGE(PG8_SB(0, 0), b2, voffB); PG8_STAGE(PG8_SB(0, 1), b2 + hstep, voffB); PG8_STAGE(PG8_SA(0, 0), a2, voffA);
            PG8_WAIT_V(8); PG8_WAIT_L(0); PG8_BAR; PG8_MMA(1, 0, At, B0); PG8_MMA(1, 1, At, B1); PG8_BAR; PG8_SCHED;
            PG8_LDB(B0, 1, 0); PG8_LDB(B1, 1, 1); PG8_SCHED; PG8_LDA(At, 1, 0); PG8_STAGE(PG8_SA(0, 1), a2 + hstep, voffA);
            PG8_WAIT_V(8); PG8_WAIT_L(0); PG8_BAR; PG8_MMA(0, 0, At, B0); PG8_MMA(0, 1, At, B1); PG8_BAR; PG8_SCHED;
            PG8_LDA(At, 1, 1); PG8_STAGE(PG8_SB(1, 0), b3, voffB); PG8_STAGE(PG8_SB(1, 1), b3 + hstep, voffB); PG8_STAGE(PG8_SA(1, 0), a3, voffA);
            PG8_WAIT_V(8); PG8_WAIT_L(0); PG8_BAR; PG8_MMA(1, 0, At, B0); PG8_MMA(1, 1, At, B1); PG8_BAR; PG8_SCHED;
            } else {
            PG8_LDB(B0, 0, 0); PG8_SCHED; PG8_LDA(At, 0, 0); PG8_STAGE(PG8_SA(1, 1), a1 + hstep, voffA);
            PG8_WAIT_L(8); PG8_BAR; PG8_WAIT_L(0); PG8_MMA(0, 0, At, B0); PG8_BAR; PG8_SCHED;
            PG8_LDB(B1, 0, 1); PG8_STAGE(PG8_SB(0, 0), b2, voffB);
            PG8_BAR; PG8_WAIT_L(0); PG8_MMA(0, 1, At, B1); PG8_BAR;
            PG8_LDA(At, 0, 1); PG8_STAGE(PG8_SA(0, 0), a2, voffA);
            PG8_BAR; PG8_WAIT_L(0); PG8_MMA(1, 0, At, B0); PG8_BAR; PG8_SCHED;
            PG8_STAGE(PG8_SB(0, 1), b2 + hstep, voffB);
            PG8_WAIT_V(6); PG8_BAR; PG8_MMA(1, 1, At, B1); PG8_BAR;
            PG8_LDB(B0, 1, 0); PG8_SCHED; PG8_LDA(At, 1, 0); PG8_STAGE(PG8_SA(0, 1), a2 + hstep, voffA);
            PG8_WAIT_L(8); PG8_BAR; PG8_WAIT_L(0); PG8_MMA(0, 0, At, B0); PG8_BAR; PG8_SCHED;
            PG8_LDB(B1, 1, 1); PG8_STAGE(PG8_SB(1, 0), b3, voffB);
            PG8_BAR; PG8_WAIT_L(0); PG8_MMA(0, 1, At, B1); PG8_BAR;
            PG8_LDA(At, 1, 1); PG8_STAGE(PG8_SA(1, 0), a3, voffA);
            PG8_BAR; PG8_WAIT_L(0); PG8_MMA(1, 0, At, B0); PG8_BAR; PG8_SCHED;
            PG8_STAGE(PG8_SB(1, 1), b3 + hstep, voffB);
            PG8_WAIT_V(6); PG8_BAR; PG8_MMA(1, 1, At, B1); PG8_BAR;
            }
        }
        if constexpr (ALIGN_EPI) { if (wr == 0) PG8_BAR; }
        if constexpr (!Epi::AFTER_DRAIN) { E(acc, cur, wr, wc, fr, fq); S.done(cur); }
        if (!has_next) break;
#pragma unroll
        for (int a = 0; a < 2; ++a)
#pragma unroll
            for (int b = 0; b < 2; ++b)
#pragma unroll
                for (int m = 0; m < 4; ++m)
#pragma unroll
                    for (int n = 0; n < 2; ++n) acc[a][b][m][n] = (f32x4){0.f, 0.f, 0.f, 0.f};
        cur = nxt; cA = nA; cB = nB; ++ui;
        if constexpr (ALIGN_EPI) { if (wr == 1) PG8_BAR; }
    }
    PG8_WAIT_V(0);
    if constexpr (!ALIGN_EPI) { if (wr == 0) PG8_BAR; }
    PG8_BAR;
    if constexpr (Epi::AFTER_DRAIN) { E.fused(acc, cur, wr, wc, fr, fq, lds, wid, lane); S.done(cur); }
#undef PG8_SA
#undef PG8_SB
#undef PG8_STAGE
#undef PG8_LDA
#undef PG8_LDB
#undef PG8_MMA
#undef PG8_WAIT_V
#undef PG8_WAIT_L
#undef PG8_BAR
#undef PG8_SCHED
}
}

constexpr int NWAVES = 8;
constexpr int BATCH = 8, SEQ = 4096, D = 1024, DEPTH = 2, M = BATCH * SEQ, IN_COLS = 2304, FF = 2816, GU = 2 * FF;
constexpr float EPS = 1e-6f, LOG2E = 1.4426950408889634f, C2 = 0.125f * LOG2E;
constexpr int NPHASE = 12;
#ifndef MK_ONE_LAUNCH
#define MK_ONE_LAUNCH 0
#endif
constexpr size_t MiB = 1u << 20;
constexpr size_t WS_CTL = 0, CTL_ZERO_BYTES = 1 * MiB;
constexpr size_t WS_SS_MIX = 2 * MiB, WS_SSY = 4 * MiB, WS_SS_FFN = 6 * MiB;
constexpr size_t WS_RS = 1 * MiB;
constexpr size_t WS_W = 8 * MiB, W_LAYER = 23 * MiB, W_IN = 0, W_OUT = 9 * MiB / 2, W_GU = 13 * MiB / 2, W_DOWN = 35 * MiB / 2;
constexpr size_t WS_ATT = 56 * MiB;
constexpr size_t WS_XB = 96 * MiB, WS_PROJ = 160 * MiB, WS_Y = 304 * MiB, WS_ACT = 160 * MiB, WS_END = 368 * MiB;
constexpr int CW_BAR = 4096;
constexpr int RING_OFF = 0, RING_BYTES = 131072;
constexpr int LDSCTL_OFF = RING_BYTES, MISC_OFF = LDSCTL_OFF + 320;
constexpr int LDS_BYTES = 147456;
#define GAS __attribute__((address_space(1)))
#define LAS __attribute__((address_space(3)))
typedef unsigned short bf16;
typedef unsigned v4u __attribute__((ext_vector_type(4)));
typedef float f32x4 __attribute__((ext_vector_type(4)));
typedef short bf16x8 __attribute__((ext_vector_type(8)));
typedef GAS unsigned gu32;
typedef GAS unsigned long long gu64;
#define RLX_AGENT __ATOMIC_RELAXED, __HIP_MEMORY_SCOPE_AGENT
#define LDS_WAIT() asm volatile("s_waitcnt lgkmcnt(0)" ::: "memory")
#define VM_WAIT() asm volatile("s_waitcnt vmcnt(0)" ::: "memory")
__device__ __forceinline__ unsigned long long rt() { return __builtin_amdgcn_s_memrealtime(); }
__device__ __forceinline__ unsigned f2bf(float f) { unsigned u = __builtin_bit_cast(unsigned, f); return (u + 0x7fffu + ((u >> 16) & 1u)) >> 16; }
__device__ __forceinline__ unsigned pk2(float lo, float hi) { return f2bf(lo) | (f2bf(hi) << 16); }

#define XB_TMO      128
#define XB_XCNT(j)  (256  + 64 * (j))
#define XB_XSUB(j)  (1280 + 64 * (j))
#define XB_XGEN(j)  (2304 + 64 * (j))
#define XB_TOP      3328
#define XB_TOPGEN   3392
#define XCD_BAR_WORDS 3456
#define XB_SPIN_CAP (1u << 18)

__device__ __forceinline__ unsigned xb_ld(unsigned* p)              { return __hip_atomic_load(p, __ATOMIC_RELAXED, __HIP_MEMORY_SCOPE_AGENT); }
__device__ __forceinline__ unsigned xb_add(unsigned* p, unsigned v) { return __hip_atomic_fetch_add(p, v, __ATOMIC_RELAXED, __HIP_MEMORY_SCOPE_AGENT); }
__device__ __forceinline__ unsigned xb_xcc_id() { return (unsigned)__builtin_amdgcn_s_getreg((3 << 11) | 20) & 0xFu; }
#define XB_SPIN(cond, bar) do { unsigned _sp = 0; while (cond) { __builtin_amdgcn_s_sleep(1); \
    if ((++_sp & 255u) == 0u) { if (xb_ld(&(bar)[XB_TMO])) break; if (_sp > XB_SPIN_CAP) { atomicAdd(&(bar)[XB_TMO], 1u); break; } } } } while (0)

struct XcdBarrier {
    unsigned* bar; unsigned x;
    volatile LAS unsigned* st;
};

__device__ __forceinline__ XcdBarrier xcd_barrier_post(unsigned* bar, volatile LAS unsigned* st) {
    XcdBarrier b; b.bar = bar; b.x = xb_xcc_id(); b.st = st;
    if (threadIdx.x == 0) (void)xb_add(&bar[XB_XCNT(b.x)], 1u);
    return b;
}
__device__ __forceinline__ void xcd_barrier_complete(unsigned* bar, unsigned x, unsigned& nloc, unsigned& nx) {
    const unsigned G = gridDim.x * gridDim.y * gridDim.z;
    unsigned sum, cnt, mine, sp = 0u;
    for (;;) {
        sum = 0u; cnt = 0u; mine = 0u;
#pragma unroll
        for (unsigned j = 0; j < 16; ++j) { const unsigned c = xb_ld(&bar[XB_XCNT(j)]); sum += c; cnt += (c > 0u) ? 1u : 0u; mine = (j == x) ? c : mine; }
        if (sum == G) break;
        __builtin_amdgcn_s_sleep(1);
        if ((++sp & 255u) == 0u) { if (xb_ld(&bar[XB_TMO])) break; if (sp > XB_SPIN_CAP) { atomicAdd(&bar[XB_TMO], 1u); break; } }
    }
    nloc = mine > 0u ? mine : 1u; nx = cnt > 0u ? cnt : 1u;
}

__device__ __forceinline__ void xcd_barrier(const XcdBarrier& b) {
    asm volatile("s_waitcnt vmcnt(0)" ::: "memory");
    __syncthreads();
    if (threadIdx.x == 0) {
        unsigned* bar = b.bar;
        __builtin_amdgcn_s_waitcnt(0);
        unsigned nloc = b.st[0], nx = b.st[1];
        if (nloc == 0u) { xcd_barrier_complete(bar, b.x, nloc, nx); b.st[0] = nloc; b.st[1] = nx; }
        const unsigned old = xb_add(&bar[XB_XSUB(b.x)], 1u);
        const unsigned gen = old / nloc;
        if (old + 1u == (gen + 1u) * nloc) {
            __builtin_amdgcn_fence(__ATOMIC_RELEASE, "agent");
            asm volatile("s_waitcnt vmcnt(0)" ::: "memory");
            const unsigned og = xb_add(&bar[XB_TOP], 1u);
            const unsigned tg = og / nx;
            if (og + 1u == (tg + 1u) * nx) xb_add(&bar[XB_TOPGEN], 1u);
            else XB_SPIN(xb_ld(&bar[XB_TOPGEN]) == tg, bar);
            __builtin_amdgcn_fence(__ATOMIC_ACQUIRE, "agent");
            xb_add(&bar[XB_XGEN(b.x)], 1u);
            asm volatile("s_waitcnt vmcnt(0)" ::: "memory");
        } else {
            XB_SPIN(xb_ld(&bar[XB_XGEN(b.x)]) == gen, bar);
            __builtin_amdgcn_fence(__ATOMIC_ACQUIRE, "agent");
            asm volatile("s_waitcnt vmcnt(0)" ::: "memory");
        }
    }
    __syncthreads();
}

namespace att {
typedef short bf16x8 __attribute__((ext_vector_type(8)));
typedef short s16x4 __attribute__((ext_vector_type(4)));
typedef float f32x16 __attribute__((ext_vector_type(16)));
typedef float f32x4 __attribute__((ext_vector_type(4)));
typedef unsigned u32x4 __attribute__((ext_vector_type(4)));
typedef unsigned u32x2 __attribute__((ext_vector_type(2)));
typedef float f32x2_t __attribute__((ext_vector_type(2))); typedef __bf16 bf16x2_t __attribute__((ext_vector_type(2)));
typedef short v4i16_t __attribute__((ext_vector_type(4)));
#define ATT_LAS __attribute__((address_space(3)))
constexpr int SPAN = 512, ST_BYTES = SPAN * 64 * 4 + SPAN * 8;
__device__ __forceinline__ unsigned cvtpk(float lo, float hi) { f32x2_t v = {lo, hi}; bf16x2_t b = __builtin_convertvector(v, bf16x2_t); return __builtin_bit_cast(unsigned, b); }
__device__ __forceinline__ s16x4 vtr(const ATT_LAS unsigned char* p) { return __builtin_bit_cast(s16x4, __builtin_amdgcn_ds_read_tr16_b64_v4i16((ATT_LAS v4i16_t*)p)); }

template <int SIDE>
__device__ __forceinline__ void block(const unsigned short* pb, int tq0, int dil, int qoff, int koff, int voff, float slope2, float& m, float& l, f32x16& o0, f32x16& o1, ATT_LAS unsigned char* vbuf, int lane) {
    constexpr int NT = (2 * SIDE + 32) / 32, LD = 2304, SEQL = 4096;
    const int u = lane & 31, hi = lane >> 5;
    bf16x8 qf[4];
    { const unsigned short* qp = pb + (size_t)(tq0 + u * dil) * LD + qoff + 8 * hi;
#pragma unroll
      for (int d0 = 0; d0 < 4; ++d0) qf[d0] = *(const bf16x8*)(qp + 16 * d0); }
    int jlo = 0, jhi = NT - 1;
    while (tq0 + dil * (32 * jlo - SIDE) < 0) ++jlo;
    while (tq0 + dil * (32 * jhi - SIDE) >= SEQL) --jhi;
    const int vkey = lane >> 2, vcol = 8 * (lane & 3);
    const ATT_LAS unsigned char* vrd = vbuf + ((lane >> 4) & 1) * 32 + (lane & 3) * 8 + (4 * hi + ((lane & 15) >> 2)) * 64;
    bf16x8 kf[4], kn[4]; u32x4 vr[4];
#define ATT_LOADK(j, dst) do { const unsigned short* kp_ = pb + (size_t)(tq0 + dil * (32 * (j) - SIDE + u)) * LD + koff + 8 * hi; \
        _Pragma("unroll") for (int d0 = 0; d0 < 4; ++d0) dst[d0] = *(const bf16x8*)(kp_ + 16 * d0); } while (0)
#define ATT_LOADV(j) do { _Pragma("unroll") for (int p_ = 0; p_ < 4; ++p_) { \
        const unsigned short* vp_ = pb + (size_t)(tq0 + dil * (32 * (j) - SIDE + 16 * (p_ & 1) + vkey)) * LD + voff + 32 * (p_ >> 1) + vcol; vr[p_] = *(const u32x4*)vp_; } } while (0)
    ATT_LOADK(jlo, kf); ATT_LOADV(jlo);
#pragma unroll
    for (int d0 = 0; d0 < 4; ++d0) kn[d0] = kf[d0];
    for (int j = jlo; j <= jhi; ++j) {
#pragma unroll
        for (int p = 0; p < 4; ++p) *(ATT_LAS u32x4*)(vbuf + p * 1024 + lane * 16) = vr[p];
        if (j < jhi) { ATT_LOADK(j + 1, kn); ATT_LOADV(j + 1); }
        f32x16 S;
#pragma unroll
        for (int r = 0; r < 16; ++r) S[r] = 0.f;
#pragma unroll
        for (int d0 = 0; d0 < 4; ++d0) S = __builtin_amdgcn_mfma_f32_32x32x16_bf16(kf[d0], qf[d0], S, 0, 0, 0);
        const float c0 = (float)(32 * j - SIDE + 4 * hi - u);
        float mx = -1e30f;
#pragma unroll
        for (int r = 0; r < 16; ++r) { const float ad = __builtin_fabsf(c0 + (float)((r & 3) + 8 * (r >> 2))); float s = S[r] - slope2 * ad; s = (ad > (float)SIDE) ? -1e30f : s; S[r] = s; mx = __builtin_fmaxf(mx, s); }
        mx = __builtin_fmaxf(mx, __shfl_xor(mx, 32));
        const float mn = __builtin_fmaxf(m, mx), alpha = __builtin_amdgcn_exp2f(m - mn); m = mn;
        float ps = 0.f;
#pragma unroll
        for (int r = 0; r < 16; ++r) { S[r] = __builtin_amdgcn_exp2f(S[r] - mn); ps += S[r]; }
        l = l * alpha + ps;
        o0 = o0 * alpha; o1 = o1 * alpha;
        u32x4 w0, w1;
        w0[0] = cvtpk(S[0], S[1]); w0[1] = cvtpk(S[2], S[3]); w0[2] = cvtpk(S[4], S[5]); w0[3] = cvtpk(S[6], S[7]);
        w1[0] = cvtpk(S[8], S[9]); w1[1] = cvtpk(S[10], S[11]); w1[2] = cvtpk(S[12], S[13]); w1[3] = cvtpk(S[14], S[15]);
        const bf16x8 pk0 = __builtin_bit_cast(bf16x8, w0), pk1 = __builtin_bit_cast(bf16x8, w1);
        {
            const s16x4 a0 = vtr(vrd), a1 = vtr(vrd + 512), b0 = vtr(vrd + 1024), b1 = vtr(vrd + 1536);
            const s16x4 c0_ = vtr(vrd + 2048), c1 = vtr(vrd + 2560), d0_ = vtr(vrd + 3072), d1 = vtr(vrd + 3584);
            const bf16x8 v00 = __builtin_shufflevector(a0, a1, 0, 1, 2, 3, 4, 5, 6, 7), v01 = __builtin_shufflevector(b0, b1, 0, 1, 2, 3, 4, 5, 6, 7);
            const bf16x8 v10 = __builtin_shufflevector(c0_, c1, 0, 1, 2, 3, 4, 5, 6, 7), v11 = __builtin_shufflevector(d0_, d1, 0, 1, 2, 3, 4, 5, 6, 7);
            o0 = __builtin_amdgcn_mfma_f32_32x32x16_bf16(v00, pk0, o0, 0, 0, 0); o0 = __builtin_amdgcn_mfma_f32_32x32x16_bf16(v01, pk1, o0, 0, 0, 0);
            o1 = __builtin_amdgcn_mfma_f32_32x32x16_bf16(v10, pk0, o1, 0, 0, 0); o1 = __builtin_amdgcn_mfma_f32_32x32x16_bf16(v11, pk1, o1, 0, 0, 0);
        }
#pragma unroll
        for (int d0 = 0; d0 < 4; ++d0) kf[d0] = kn[d0];
    }
#undef ATT_LOADK
#undef ATT_LOADV
}
__device__ __forceinline__ void finish(float l, const f32x16& o0, const f32x16& o1, unsigned short* yrow, float* ssyp, int hi) {
    const float lt = l + __shfl_xor(l, 32), inv = 1.0f / lt; float sq = 0.f;
#pragma unroll
    for (int g = 0; g < 4; ++g) {
        const float a0 = o0[4 * g] * inv, a1 = o0[4 * g + 1] * inv, a2 = o0[4 * g + 2] * inv, a3 = o0[4 * g + 3] * inv;
        const float b0 = o1[4 * g] * inv, b1 = o1[4 * g + 1] * inv, b2 = o1[4 * g + 2] * inv, b3 = o1[4 * g + 3] * inv;
        sq += ((a0 * a0 + a1 * a1) + (a2 * a2 + a3 * a3)) + ((b0 * b0 + b1 * b1) + (b2 * b2 + b3 * b3));
        u32x2 wa, wb; wa[0] = cvtpk(a0, a1); wa[1] = cvtpk(a2, a3); wb[0] = cvtpk(b0, b1); wb[1] = cvtpk(b2, b3);
        *(u32x2*)(yrow + 8 * g + 4 * hi) = wa; *(u32x2*)(yrow + 32 + 8 * g + 4 * hi) = wb;
    }
    sq += __shfl_xor(sq, 32);
    if (hi == 0) *ssyp = sq;
}
__device__ __forceinline__ void phase(const unsigned short* proj, const float* sink, unsigned short* Y, float* SSY, unsigned char* state_ws, ATT_LAS unsigned char* lds, int vcu, int G) {
    constexpr int LD = 2304, SEQL = 4096, NB = 8, NITEM = 2 * NB * 8 * (SEQL / SPAN);
    int tid_ = threadIdx.x; asm volatile("" : "+v"(tid_));
    const int lane = tid_ & 63, wave = __builtin_amdgcn_readfirstlane(tid_ >> 6), u = lane & 31, hi = lane >> 5;
    ATT_LAS unsigned char* vbuf = lds + wave * 4096;
    float* stO = (float*)(state_ws + (size_t)blockIdx.x * ST_BYTES); float* stML = stO + SPAN * 64;
    for (int it = vcu; it < NITEM; it += G) {
        const bool dg = it < NITEM / 2; const int id = dg ? it : it - NITEM / 2;
        const int span = id & 7, h = (id >> 3) & 7, b = id >> 6, tok0 = span * SPAN, h16 = dg ? h : 8 + h;
        const unsigned short* pb = proj + (size_t)b * SEQL * LD;
        const float slope = __builtin_amdgcn_exp2f(-0.5f * (float)((dg ? 8 + h : h) + 1)) * 1.4426950408889634f;
        if (dg) {
            const int qoff = h * 64, koff = 512 + h * 64, voff = 1024 + h * 64;
#pragma unroll 1
            for (int pass = 0; pass < 3; ++pass) {
                const int dil = pass == 0 ? 16 : (pass == 1 ? 4 : 1);
#pragma unroll 1
                for (int k = 0; k < 2; ++k) {
                    const int bi = wave + 8 * k;
                    const int tq0 = tok0 + (pass == 0 ? bi : (pass == 1 ? 128 * (bi >> 2) + (bi & 3) : 32 * bi));
                    const int ts = tq0 - tok0 + u * dil;
                    float m, l; f32x16 o0, o1;
                    if (pass == 0) { m = -1e30f; l = 0.f;
#pragma unroll
                        for (int r = 0; r < 16; ++r) { o0[r] = 0.f; o1[r] = 0.f; } }
                    else { const f32x2_t ml = *(const f32x2_t*)(stML + 2 * ts); m = ml[0]; l = hi == 0 ? ml[1] : 0.f;
#pragma unroll
                        for (int g = 0; g < 4; ++g) { const f32x4 a = *(const f32x4*)(stO + ts * 64 + 8 * g + 4 * hi), c = *(const f32x4*)(stO + ts * 64 + 32 + 8 * g + 4 * hi);
                            o0[4 * g] = a[0]; o0[4 * g + 1] = a[1]; o0[4 * g + 2] = a[2]; o0[4 * g + 3] = a[3]; o1[4 * g] = c[0]; o1[4 * g + 1] = c[1]; o1[4 * g + 2] = c[2]; o1[4 * g + 3] = c[3]; } }
                    block<64>(pb, tq0, dil, qoff, koff, voff, slope * (float)dil, m, l, o0, o1, vbuf, lane);
                    if (pass < 2) { const float lt = l + __shfl_xor(l, 32);
                        if (hi == 0) { f32x2_t ml; ml[0] = m; ml[1] = lt; *(f32x2_t*)(stML + 2 * ts) = ml; }
#pragma unroll
                        for (int g = 0; g < 4; ++g) { f32x4 a, c; a[0] = o0[4 * g]; a[1] = o0[4 * g + 1]; a[2] = o0[4 * g + 2]; a[3] = o0[4 * g + 3]; c[0] = o1[4 * g]; c[1] = o1[4 * g + 1]; c[2] = o1[4 * g + 2]; c[3] = o1[4 * g + 3];
                            *(f32x4*)(stO + ts * 64 + 8 * g + 4 * hi) = a; *(f32x4*)(stO + ts * 64 + 32 + 8 * g + 4 * hi) = c; } }
                    else { const size_t tok = (size_t)b * SEQL + tq0 + u; finish(l, o0, o1, Y + tok * 1024 + h16 * 64, SSY + tok * 16 + h16, hi); }
                }
                __syncthreads();
            }
        } else {
            const int qoff = 1536 + h * 64, koff = 2048 + (h >> 2) * 64, voff = 2176 + (h >> 2) * 64;
            const float sk2 = sink[h] * 1.4426950408889634f;
#pragma unroll 1
            for (int k = 0; k < 2; ++k) {
                const int tq0 = tok0 + 32 * (wave + 8 * k);
                float m = sk2, l = hi == 0 ? 1.0f : 0.f; f32x16 o0, o1;
#pragma unroll
                for (int r = 0; r < 16; ++r) { o0[r] = 0.f; o1[r] = 0.f; }
                block<128>(pb, tq0, 1, qoff, koff, voff, slope, m, l, o0, o1, vbuf, lane);
                const size_t tok = (size_t)b * SEQL + tq0 + u; finish(l, o0, o1, Y + tok * 1024 + h16 * 64, SSY + tok * 16 + h16, hi);
            }
        }
    }
    __syncthreads();
}
#undef ATT_LAS
}

struct Frame {
    LAS unsigned char* lds;
    volatile LAS unsigned* MISC;
    gu32* ctl;
    int tid, lane, wave;
    int vcu, G;
};
__device__ __forceinline__ float wave_sum(float v) {
#pragma unroll
    for (int o = 1; o < 64; o <<= 1) v += __shfl_xor(v, o);
    return v;
}
__device__ __forceinline__ void p0_item(const float* W, int K, int N, bf16* WT, int out_row0, const float* gk, float nscale, LAS float* scr, int k0, int n0, int lane) {
#pragma unroll 8
    for (int i = 0; i < 32; ++i) { const int kk = 2 * i + (lane >> 5); const float g = gk ? gk[k0 + kk] : 1.0f; scr[kk * 33 + (lane & 31)] = W[(size_t)(k0 + kk) * N + n0 + (lane & 31)] * (g * nscale); }
    LDS_WAIT(); asm volatile("" ::: "memory");
    const int c = lane & 7;
#pragma unroll
    for (int j = 0; j < 4; ++j) { const int n = (lane >> 3) + 8 * j; const LAS float* s = scr + (8 * c) * 33 + n;
        v4u o; o.x = pk2(s[0 * 33], s[1 * 33]); o.y = pk2(s[2 * 33], s[3 * 33]); o.z = pk2(s[4 * 33], s[5 * 33]); o.w = pk2(s[6 * 33], s[7 * 33]);
        *(GAS v4u*)(WT + (size_t)(out_row0 + n) * K + k0 + 8 * c) = o; }
    LDS_WAIT(); asm volatile("" ::: "memory");
}
struct Ptrs {
    const float *x, *g_mix, *w_in, *g_out_dil, *g_out_win, *sink, *w_out, *g_ffn, *w_gate, *w_up, *w_down, *g_final;
    float* out; unsigned char* ws;
};
__device__ __forceinline__ void p0_prologue(Frame& F, const Ptrs& P) {
    LAS float* scr = (LAS float*)(F.lds + RING_OFF + F.wave * 16384);
    const int gw = F.vcu * NWAVES + F.wave, NGW = F.G * NWAVES;
    constexpr int I_IN = (D / 64) * (IN_COLS / 32), I_OUT = (D / 64) * (D / 32), I_G = (D / 64) * (FF / 32), I_D = (FF / 64) * (D / 32);
    constexpr int I_LAYER = I_IN + I_OUT + 2 * I_G + I_D;
    for (int it = gw; it < DEPTH * I_LAYER; it += NGW) {
        const int L = it / I_LAYER; int r = it % I_LAYER;
        bf16* wl = (bf16*)(P.ws + WS_W + (size_t)L * W_LAYER);
        if (r < I_IN) { const int nblk = IN_COLS / 32, kb = r / nblk, nb = r % nblk, n0 = 32 * nb; const bool isq = (n0 < 512) || (n0 >= 1536 && n0 < 2048);
            p0_item(P.w_in + (size_t)L * D * IN_COLS, D, IN_COLS, (bf16*)((unsigned char*)wl + W_IN), n0, P.g_mix + L * D, isq ? C2 : 1.0f, scr, 64 * kb, n0, F.lane); continue; } r -= I_IN;
        if (r < I_OUT) { const int nblk = D / 32, kb = r / nblk, nb = r % nblk, n0 = 32 * nb, k0 = 64 * kb;
            const float* gk = (k0 < 512) ? (P.g_out_dil + L * 512) : (P.g_out_win + L * 512 - 512);
            p0_item(P.w_out + (size_t)L * D * D, D, D, (bf16*)((unsigned char*)wl + W_OUT), n0, gk, 1.0f, scr, k0, n0, F.lane); continue; } r -= I_OUT;
        if (r < 2 * I_G) { const bool up = r >= I_G; if (up) r -= I_G; const int nblk = FF / 32, kb = r / nblk, nb = r % nblk, n0 = 32 * nb;
            const int orow = 256 * (n0 / 128) + (up ? 128 : 0) + (n0 % 128);
            p0_item((up ? P.w_up : P.w_gate) + (size_t)L * D * FF, D, FF, (bf16*)((unsigned char*)wl + W_GU), orow, P.g_ffn + L * D, 1.0f, scr, 64 * kb, n0, F.lane); continue; } r -= 2 * I_G;
        { const int nblk = D / 32, kb = r / nblk, nb = r % nblk, n0 = 32 * nb;
            p0_item(P.w_down + (size_t)L * FF * D, FF, D, (bf16*)((unsigned char*)wl + W_DOWN), n0, nullptr, 1.0f, scr, 64 * kb, n0, F.lane); }
    }
    bf16* XB = (bf16*)(P.ws + WS_XB); float* ss = (float*)(P.ws + WS_SS_MIX);
    for (int m = gw; m < M; m += NGW) {
        const GAS f32x4* xr = (const GAS f32x4*)(P.x + (size_t)m * D) + F.lane;
        f32x4 v[4]; float s = 0.f;
#pragma unroll
        for (int j = 0; j < 4; ++j) { v[j] = xr[64 * j]; s += (v[j].x * v[j].x + v[j].y * v[j].y) + (v[j].z * v[j].z + v[j].w * v[j].w); }
        s = wave_sum(s);
        GAS unsigned long long* o8 = (GAS unsigned long long*)(XB + (size_t)m * D) + F.lane;
#pragma unroll
        for (int j = 0; j < 4; ++j) o8[64 * j] = (unsigned long long)pk2(v[j].x, v[j].y) | ((unsigned long long)pk2(v[j].z, v[j].w) << 32);
        if (F.lane < 16) ss[(size_t)m * 16 + F.lane] = (F.lane == 0) ? s : 0.f;
    }
}
__device__ __forceinline__ void final_norm(Frame& F, const Ptrs& P) {
    const int gw = F.vcu * NWAVES + F.wave, NGW = F.G * NWAVES; const float* ss = (const float*)(P.ws + WS_SS_MIX);
    f32x4 g[4];
#pragma unroll
    for (int j = 0; j < 4; ++j) g[j] = ((const GAS f32x4*)P.g_final)[F.lane + 64 * j];
    for (int m = gw; m < M; m += NGW) {
        GAS f32x4* xr = (GAS f32x4*)(P.out + (size_t)m * D) + F.lane;
        const float rs = __builtin_amdgcn_rsqf(pg8::ss_row_sum(ss, m) * (1.0f / 1024.0f) + EPS);
#pragma unroll
        for (int j = 0; j < 4; ++j) { f32x4 v = xr[64 * j]; v = v * rs * g[j]; xr[64 * j] = v; }
    }
}
template <int MODE> __device__ __forceinline__ void rs_prepass(const pg8::StaticOrder& S, const float* ss, float* tab, int tid) {
    pg8::Unit u;
    for (int i = 0; S.next(i, u); ++i)
        for (int r = tid; r < 256; r += NWAVES * 64) { const int row = u.pm * 256 + r;
            const f32x4* p = (const f32x4*)(ss + (size_t)row * 16); const f32x4 a = p[0], b = p[1], c = p[2], d = p[3];
            const float s0 = ((a[0] + a[1]) + (a[2] + a[3])) + ((b[0] + b[1]) + (b[2] + b[3])), s1 = ((c[0] + c[1]) + (c[2] + c[3])) + ((d[0] + d[1]) + (d[2] + d[3]));
            if (MODE == 0) tab[row] = __builtin_amdgcn_rsqf((s0 + s1) * (1.0f / 1024.0f) + EPS);
            else { const float ra = __builtin_amdgcn_rsqf(s0 * (1.0f / 512.0f) + EPS), rb = __builtin_amdgcn_rsqf(s1 * (1.0f / 512.0f) + EPS); pg8::f32x2 v; v[0] = ra * __builtin_amdgcn_rcpf(rb); v[1] = rb; ((pg8::f32x2*)tab)[row] = v; } }
    __syncthreads();
}

struct Args { const float* in[12]; float* out; unsigned char* ws; int ph_lo, ph_hi, li, pad; };
__global__ void __launch_bounds__(NWAVES * 64, 2) mk_fwd(Args args) {
    extern __shared__ __attribute__((aligned(16))) unsigned char lds[];
    Frame F;
    F.lds = (LAS unsigned char*)lds;
    F.MISC = (volatile LAS unsigned*)(F.lds + MISC_OFF);
    F.tid = threadIdx.x; F.lane = F.tid & 63; F.wave = __builtin_amdgcn_readfirstlane(F.tid >> 6);
    F.G = gridDim.x; { const int bx = blockIdx.x; F.vcu = (F.G % 8 == 0) ? (bx % 8) * (F.G / 8) + bx / 8 : bx; }
    unsigned char* ws = args.ws;
    F.ctl = (gu32*)(ws + WS_CTL);
    Ptrs P; P.x = args.in[0]; P.g_mix = args.in[1]; P.w_in = args.in[2]; P.g_out_dil = args.in[3]; P.g_out_win = args.in[4]; P.sink = args.in[5]; P.w_out = args.in[6];
    P.g_ffn = args.in[7]; P.w_gate = args.in[8]; P.w_up = args.in[9]; P.w_down = args.in[10]; P.g_final = args.in[11]; P.out = args.out; P.ws = ws;
    for (int u = F.tid; u < (LDS_BYTES - LDSCTL_OFF) / 4; u += NWAVES * 64) ((LAS unsigned*)(F.lds + LDSCTL_OFF))[u] = 0u;
    __syncthreads();
    XcdBarrier bar; bar.bar = (unsigned*)(F.ctl + CW_BAR); bar.x = 0; bar.st = nullptr;
    if (MK_ONE_LAUNCH) bar = xcd_barrier_post((unsigned*)(F.ctl + CW_BAR), F.MISC + 8);
    const int lo = args.ph_lo, hi = args.ph_hi;
#define IN(k) (lo <= (k) && (k) < hi)
#define SEAM(k) do { if (MK_ONE_LAUNCH && IN(k) && IN((k) + 1)) xcd_barrier(bar); } while (0)
    bf16* XB = (bf16*)(ws + WS_XB); bf16* PROJ = (bf16*)(ws + WS_PROJ); bf16* Y = (bf16*)(ws + WS_Y); bf16* ACT = (bf16*)(ws + WS_ACT);
    float* SS_MIX = (float*)(ws + WS_SS_MIX); float* SSY = (float*)(ws + WS_SSY); float* SS_FFN = (float*)(ws + WS_SS_FFN); float* RS = (float*)(ws + WS_RS);

    if (IN(0)) { p0_prologue(F, P); } SEAM(0);
    for (int L = 0; L < DEPTH; ++L) {
        const int pb = 1 + 5 * L;
        const unsigned char* wl = ws + WS_W + (size_t)L * W_LAYER;
        if (IN(pb)) {
            pg8::Gemm g{XB, (const bf16*)(wl + W_IN), M, IN_COLS, D}; pg8::StaticOrder S; S.init(M, IN_COLS, F.G, (int)blockIdx.x);
            rs_prepass<0>(S, SS_MIX, RS, F.tid); pg8::EpiProj E{PROJ, IN_COLS, RS};
            pg8::gemm_phase<pg8::EpiProj, pg8::StaticOrder, true, true>(F.lds + RING_OFF, g, S, E);
        } SEAM(pb);
        if (IN(pb + 1)) { att::phase(PROJ, P.sink + L * 8, Y, SSY, ws + WS_ATT, F.lds + RING_OFF, F.vcu, F.G); } SEAM(pb + 1);
        if (IN(pb + 2)) {
            pg8::Gemm g{Y, (const bf16*)(wl + W_OUT), M, D, D}; pg8::StaticOrder S; S.init(M, D, F.G, (int)blockIdx.x);
            rs_prepass<1>(S, SSY, RS, F.tid); pg8::EpiRes<true> E{L == 0 ? P.x : P.out, P.out, XB, SS_FFN, (const pg8::f32x2*)RS};
            pg8::gemm_phase<pg8::EpiRes<true>, pg8::StaticOrder, true, true>(F.lds + RING_OFF, g, S, E);
        } SEAM(pb + 2);
        if (IN(pb + 3)) {
            pg8::Gemm g{XB, (const bf16*)(wl + W_GU), M, GU, D}; pg8::StaticOrder S; S.init(M, GU, F.G, (int)blockIdx.x);
            rs_prepass<0>(S, SS_FFN, RS, F.tid); pg8::EpiSwiglu E{ACT, FF, RS};
            pg8::gemm_phase<pg8::EpiSwiglu, pg8::StaticOrder, true, true>(F.lds + RING_OFF, g, S, E);
        } SEAM(pb + 3);
        if (IN(pb + 4)) {
            pg8::Gemm g{ACT, (const bf16*)(wl + W_DOWN), M, D, FF}; pg8::StaticOrder S; S.init(M, D, F.G, (int)blockIdx.x);
            pg8::EpiRes<false> E{P.out, P.out, XB, SS_MIX, nullptr};
            pg8::gemm_phase<pg8::EpiRes<false>, pg8::StaticOrder, true, true>(F.lds + RING_OFF, g, S, E);
        } SEAM(pb + 4);
    }
    if (IN(11)) { final_norm(F, P); }
#undef IN
#undef SEAM
}

extern "C" void kernel_launch(void* const* d_in, const int* in_sizes, int n_in, void* d_out, int out_size, void* d_ws, size_t ws_size, hipStream_t stream) {
    static int grid = 0;
    if (grid == 0) {
        if (n_in != 12 || in_sizes[0] != M * D || out_size != M * D || ws_size < WS_END) { fprintf(stderr, "kernel_launch: unexpected sizes (n_in %d, in0 %d, out %d, ws %zu); nothing launched\n", n_in, n_in > 0 ? in_sizes[0] : -1, out_size, ws_size); grid = -1; return; }
        int dev = 0, cus = 0, per_cu = 0;
        if (hipGetDevice(&dev) != hipSuccess || hipDeviceGetAttribute(&cus, hipDeviceAttributeMultiprocessorCount, dev) != hipSuccess) { fprintf(stderr, "kernel_launch: device query failed\n"); grid = -1; return; }
        if (hipFuncSetAttribute((const void*)mk_fwd, hipFuncAttributeMaxDynamicSharedMemorySize, LDS_BYTES) != hipSuccess) { fprintf(stderr, "kernel_launch: hipFuncSetAttribute failed\n"); grid = -1; return; }
        if (hipOccupancyMaxActiveBlocksPerMultiprocessor(&per_cu, (const void*)mk_fwd, NWAVES * 64, LDS_BYTES) != hipSuccess || per_cu < 1) { fprintf(stderr, "kernel_launch: occupancy query reports %d workgroups per CU\n", per_cu); (void)hipGetLastError(); grid = -1; return; }
        grid = cus;
    }
    if (grid < 0) return;
    if (hipMemsetAsync((char*)d_ws + WS_CTL, 0, CTL_ZERO_BYTES, stream) != hipSuccess) { fprintf(stderr, "kernel_launch: memset failed\n"); return; }
    Args a{};
    for (int i = 0; i < 12; ++i) a.in[i] = (const float*)d_in[i];
    a.out = (float*)d_out; a.ws = (unsigned char*)d_ws;
#if MK_ONE_LAUNCH
    a.ph_lo = 0; a.ph_hi = NPHASE; a.li = 0;
    hipLaunchKernelGGL(mk_fwd, dim3(grid), dim3(NWAVES * 64), LDS_BYTES, stream, a);
#else
    for (int p = 0; p < NPHASE; ++p) { a.ph_lo = p; a.ph_hi = p + 1; a.li = p; hipLaunchKernelGGL(mk_fwd, dim3(grid), dim3(NWAVES * 64), LDS_BYTES, stream, a); }
#endif
    const hipError_t le = hipPeekAtLastError();
    if (le != hipSuccess) fprintf(stderr, "kernel_launch: launch failed: %s\n", hipGetErrorName(le));
}
```

```cpp
#define MK_ONE_LAUNCH 1
#include <hip/hip_runtime.h>
#include <cstdio>
#include <cstdint>
namespace pg8 {
#define PG8_LAS __attribute__((address_space(3)))
typedef unsigned short bf16_t;
typedef short bf16x8 __attribute__((ext_vector_type(8)));
typedef float f32x4 __attribute__((ext_vector_type(4)));
typedef unsigned u32x4 __attribute__((ext_vector_type(4)));
constexpr int BM = 256, BK = 64, HALF = 128, HTB = HALF * BK * 2  , STAGE_BYTES = 8 * HTB, NXCD = 8, WGM = 8;

__host__ __device__ __forceinline__ int lds_byte(int r, int c) { const int st = (r >> 4) * 2 + (c >> 5), rr = r & 15, cc = c & 31, ob = rr * 64 + cc * 2; return st * 1024 + (ob ^ (((ob >> 9) & 1) << 5)); }
__host__ __device__ __forceinline__ void stage_rc(int b, int& R, int& C) { const int st = b / 1024, sb = b % 1024, swz = sb ^ (((sb >> 9) & 1) << 5); R = (st >> 1) * 16 + swz / 64; C = (st & 1) * 32 + (swz % 64) / 2; }
__host__ __device__ __forceinline__ int perm32(int rho) { const int n = rho >> 4, i = rho & 15; return 8 * (i >> 2) + 4 * n + (i & 3); }

struct Unit { int pm, pn; };
struct Gemm { const bf16_t* A; const bf16_t* Bt; int M, N, K; };

struct StaticOrder {
    int nM, nN, nwg, G, c;
    __host__ __device__ void init(int M, int N, int G_, int c_) { nM = M / BM; nN = N / BM; nwg = nM * nN; G = G_; c = c_; }
    __host__ __device__ bool next(int i, Unit& u) const {
        const long L = (long)i * G + c; if (L >= nwg) return false;
        int wgid = (int)L; { const int q = nwg / NXCD, r = nwg % NXCD, xcd = wgid % NXCD, off = wgid / NXCD; wgid = (xcd < r ? xcd * (q + 1) : r * (q + 1) + (xcd - r) * q) + off; }
        const int nig = WGM * nN, gid = wgid / nig, fm = gid * WGM, gsz = (nM - fm) < WGM ? (nM - fm) : WGM;
        u.pm = fm + ((wgid % nig) % gsz); u.pn = (wgid % nig) / gsz; return true;
    }
    __device__ __forceinline__ void a_ready(const Unit&) const {}
    __device__ __forceinline__ void done(const Unit&) const {}
};


__device__ __forceinline__ unsigned cvt_pk_bf16(float lo, float hi) { unsigned r; asm volatile("v_cvt_pk_bf16_f32 %0, %1, %2" : "=v"(r) : "v"(lo), "v"(hi)); return r; }
typedef float f32x2 __attribute__((ext_vector_type(2)));
typedef unsigned u32x2 __attribute__((ext_vector_type(2)));
constexpr int NSS = 16;
__device__ __forceinline__ float ss_row_sum(const float* ss, int row) {
    const f32x4* p = (const f32x4*)(ss + (size_t)row * NSS);
    const f32x4 a = p[0], b = p[1], c = p[2], d = p[3];
    return ((a[0] + a[1]) + (a[2] + a[3])) + ((b[0] + b[1]) + (b[2] + b[3])) + ((c[0] + c[1]) + (c[2] + c[3])) + ((d[0] + d[1]) + (d[2] + d[3]));
}
struct EpiProj {
    static constexpr bool PERM = true, AFTER_DRAIN = false, MID = false; static constexpr int MID_T = -1;
    bf16_t* O; int ldc; const float* rs_tab;
    __device__ __forceinline__ void mid(f32x4 (&acc)[2][2][4][2], const Unit& u, int wr, int wc, int fr, int fq) const {}
    __device__ __forceinline__ void operator()(const f32x4 (&acc)[2][2][4][2], const Unit& u, int wr, int wc, int fr, int fq) const {
        const int row0 = u.pm * BM + wr * 64 + fr, col0 = u.pn * BM + wc * 32 + 8 * fq;
#pragma unroll
        for (int ai = 0; ai < 2; ++ai)
#pragma unroll
            for (int m = 0; m < 4; ++m) { const int row = row0 + ai * HALF + m * 16;
                const float rs = rs_tab[row];
                bf16_t* rowp = O + (size_t)row * ldc + col0;
#pragma unroll
                for (int bj = 0; bj < 2; ++bj) { const f32x4 v0 = acc[ai][bj][m][0] * rs, v1 = acc[ai][bj][m][1] * rs;
                    u32x4 w; w.x = cvt_pk_bf16(v0[0], v0[1]); w.y = cvt_pk_bf16(v0[2], v0[3]); w.z = cvt_pk_bf16(v1[0], v1[1]); w.w = cvt_pk_bf16(v1[2], v1[3]);
                    *(u32x4*)(rowp + bj * HALF) = w; }
                if (m & 1) asm volatile("" ::: "memory"); }
    }
};
struct EpiSwiglu {
    static constexpr bool PERM = true, AFTER_DRAIN = false, MID = false; static constexpr int MID_T = -1;
    bf16_t* O; int ldc; const float* rs_tab;
    __device__ __forceinline__ void mid(f32x4 (&acc)[2][2][4][2], const Unit& u, int wr, int wc, int fr, int fq) const {}
    __device__ __forceinline__ float act1(float g, float up, float rs) const { const float z = g * rs; return z * __builtin_amdgcn_rcpf(1.0f + __builtin_amdgcn_exp2f(z * -1.4426950408889634f)) * (up * rs); }
    __device__ __forceinline__ void operator()(const f32x4 (&acc)[2][2][4][2], const Unit& u, int wr, int wc, int fr, int fq) const {
        const int row0 = u.pm * BM + wr * 64 + fr, col0 = u.pn * HALF + wc * 32 + 8 * fq;
#pragma unroll
        for (int ai = 0; ai < 2; ++ai)
#pragma unroll
            for (int m = 0; m < 4; ++m) { const int row = row0 + ai * HALF + m * 16;
                const float rs = rs_tab[row];
                const f32x4 g0 = acc[ai][0][m][0], g1 = acc[ai][0][m][1], u0 = acc[ai][1][m][0], u1 = acc[ai][1][m][1];
                u32x4 w; w.x = cvt_pk_bf16(act1(g0[0], u0[0], rs), act1(g0[1], u0[1], rs)); w.y = cvt_pk_bf16(act1(g0[2], u0[2], rs), act1(g0[3], u0[3], rs));
                w.z = cvt_pk_bf16(act1(g1[0], u1[0], rs), act1(g1[1], u1[1], rs)); w.w = cvt_pk_bf16(act1(g1[2], u1[2], rs), act1(g1[3], u1[3], rs));
                *(u32x4*)(O + (size_t)row * ldc + col0) = w;
                if (m & 1) asm volatile("" ::: "memory"); }
    }
};
template <bool YSCALE> struct EpiRes {
    static constexpr bool PERM = false, AFTER_DRAIN = false, MID = YSCALE; static constexpr int MID_T = 8;
    bf16_t* xb; float* ssout; const f32x2* ys;
    __device__ __forceinline__ void mid(f32x4 (&acc)[2][2][4][2], const Unit& u, int wr, int wc, int fr, int fq) const {
        if constexpr (YSCALE) {
            const int row0 = u.pm * BM + wr * 64 + fr;
#pragma unroll
            for (int ai = 0; ai < 2; ++ai)
#pragma unroll
                for (int m = 0; m < 4; ++m) { const float f = ys[row0 + ai * HALF + m * 16][0];
#pragma unroll
                    for (int bj = 0; bj < 2; ++bj)
#pragma unroll
                        for (int n = 0; n < 2; ++n) acc[ai][bj][m][n] *= f;
                    if (m & 1) asm volatile("" ::: "memory"); }
        }
    }
    __device__ __forceinline__ void operator()(const f32x4 (&acc)[2][2][4][2], const Unit& u, int wr, int wc, int fr, int fq) const {
        const int row0 = u.pm * BM + wr * 64 + fr, col0 = u.pn * BM + wc * 32 + 4 * fq;
#pragma unroll
        for (int ai = 0; ai < 2; ++ai)
#pragma unroll
            for (int m = 0; m < 4; ++m) { const int row = row0 + ai * HALF + m * 16; const size_t off = (size_t)row * 1024 + col0;
                float fs = 1.0f; if constexpr (YSCALE) fs = ys[row][1];
                float q = 0.f;
#pragma unroll
                for (int bj = 0; bj < 2; ++bj)
#pragma unroll
                    for (int n = 0; n < 2; ++n) { const u32x2 bb = *(const u32x2*)(xb + off + bj * HALF + n * 16);
                        f32x4 bs; bs[0] = __uint_as_float(bb[0] << 16); bs[1] = __uint_as_float(bb[0] & 0xffff0000u); bs[2] = __uint_as_float(bb[1] << 16); bs[3] = __uint_as_float(bb[1] & 0xffff0000u);
                        const f32x4 o = bs + acc[ai][bj][m][n] * fs;
                        u32x2 w; w.x = cvt_pk_bf16(o[0], o[1]); w.y = cvt_pk_bf16(o[2], o[3]); *(u32x2*)(xb + off + bj * HALF + n * 16) = w;
                        q += (o[0] * o[0] + o[1] * o[1]) + (o[2] * o[2] + o[3] * o[3]); }
                q += __shfl_xor(q, 16); q += __shfl_xor(q, 32);
                if (fq == 0) ssout[(size_t)row * NSS + u.pn * 4 + wc] = q;
                if (m & 1) asm volatile("" ::: "memory"); }
    }
};
template <class Epi, class Sched, bool ALIGN_EPI = false, bool SP2 = false>
__device__ __forceinline__ void gemm_phase(PG8_LAS unsigned char* lds, const Gemm g, const Sched& S, const Epi& E) {
    int tid_ = threadIdx.x; asm volatile("" : "+v"(tid_));
    const int tid = tid_, wid = __builtin_amdgcn_readfirstlane(tid >> 6), lane = tid & 63, wr = wid >> 2, wc = wid & 3, fr = lane & 15, fq = lane >> 4;
    const int K = g.K, nt = K / BK;
    unsigned voffA[2], voffB[2];
#pragma unroll
    for (int i = 0; i < 2; ++i) { int R, C; stage_rc(tid * 16 + i * 8192, R, C); const int Rb = Epi::PERM ? ((R & ~31) + perm32(R & 31)) : R;
        voffA[i] = (unsigned)(R * K + C) * 2u; voffB[i] = (unsigned)(Rb * K + C) * 2u; }
    const size_t kstep = (size_t)(BK * 2);
    const size_t hstep = (size_t)HALF * K * 2;
    const size_t tstep = 2 * hstep;
    const unsigned ldsw = (unsigned)wid * 1024u;
    const int aoff = lds_byte(wr * 64 + fr, fq * 8), boff = lds_byte(wc * 32 + fr, fq * 8);
#define PG8_SA(b, h) (((b) * 2 + (h)) * HTB)
#define PG8_SB(b, h) ((4 + (b) * 2 + (h)) * HTB)
#define PG8_STAGE(bufoff, gbase, voff) do { _Pragma("unroll") for (int _i = 0; _i < 2; ++_i) \
        __builtin_amdgcn_global_load_lds((const unsigned*)((const char*)(gbase) + (voff)[_i]), (PG8_LAS unsigned*)(lds + (bufoff) + ldsw + _i * 8192), 16, 0, 0); } while (0)
#define PG8_LDA(dst, b, h) do { _Pragma("unroll") for (int m = 0; m < 4; ++m) _Pragma("unroll") for (int k = 0; k < 2; ++k) dst[m][k] = *(const PG8_LAS bf16x8*)(lds + PG8_SA(b, h) + aoff + m * 2048 + k * 1024); } while (0)
#define PG8_LDB(dst, b, h) do { _Pragma("unroll") for (int n = 0; n < 2; ++n) _Pragma("unroll") for (int k = 0; k < 2; ++k) dst[n][k] = *(const PG8_LAS bf16x8*)(lds + PG8_SB(b, h) + boff + n * 2048 + k * 1024); } while (0)
#define PG8_MMA(ai, bj, At, Bt) do { __builtin_amdgcn_s_setprio(1); _Pragma("unroll") for (int m = 0; m < 4; ++m) _Pragma("unroll") for (int n = 0; n < 2; ++n) _Pragma("unroll") for (int k = 0; k < 2; ++k) \
        acc[ai][bj][m][n] = __builtin_amdgcn_mfma_f32_16x16x32_bf16(Bt[n][k], At[m][k], acc[ai][bj][m][n], 0, 0, 0); __builtin_amdgcn_s_setprio(0); } while (0)
#define PG8_WAIT_V(n) asm volatile("s_waitcnt vmcnt(" #n ")" ::: "memory")
#define PG8_WAIT_L(n) asm volatile("s_waitcnt lgkmcnt(" #n ")" ::: "memory")
#define PG8_BAR __builtin_amdgcn_s_barrier()
#define PG8_SCHED __builtin_amdgcn_sched_barrier(0)
    Unit cur, nxt; int ui = 0;
    if (!S.next(0, cur)) return;
    f32x4 acc[2][2][4][2];
#pragma unroll
    for (int a = 0; a < 2; ++a)
#pragma unroll
        for (int b = 0; b < 2; ++b)
#pragma unroll
            for (int m = 0; m < 4; ++m)
#pragma unroll
                for (int n = 0; n < 2; ++n) acc[a][b][m][n] = (f32x4){0.f, 0.f, 0.f, 0.f};
    bf16x8 At[4][2], B0[2][2], B1[2][2];
    const char* cA = (const char*)g.A + (size_t)cur.pm * tstep; const char* cB = (const char*)g.Bt + (size_t)cur.pn * tstep;
    S.a_ready(cur);
    if constexpr (SP2) {
        PG8_STAGE(PG8_SB(0, 0), cB, voffB); PG8_STAGE(PG8_SB(0, 1), cB + hstep, voffB); PG8_STAGE(PG8_SA(0, 0), cA, voffA); PG8_STAGE(PG8_SA(0, 1), cA + hstep, voffA);
        if (wr == 1) PG8_BAR;
        PG8_WAIT_V(2); PG8_BAR;
        PG8_STAGE(PG8_SB(1, 0), cB + kstep, voffB); PG8_STAGE(PG8_SA(1, 0), cA + kstep, voffA); PG8_STAGE(PG8_SB(1, 1), cB + hstep + kstep, voffB);
        PG8_WAIT_V(6); PG8_BAR;
    } else {
        PG8_STAGE(PG8_SB(0, 0), cB, voffB); PG8_STAGE(PG8_SA(0, 0), cA, voffA); PG8_STAGE(PG8_SB(0, 1), cB + hstep, voffB); PG8_STAGE(PG8_SA(0, 1), cA + hstep, voffA);
        if (wr == 1) PG8_BAR;
        PG8_WAIT_V(4); PG8_BAR;
        PG8_STAGE(PG8_SB(1, 0), cB + kstep, voffB); PG8_STAGE(PG8_SA(1, 0), cA + kstep, voffA); PG8_STAGE(PG8_SB(1, 1), cB + hstep + kstep, voffB);
        PG8_WAIT_V(6); PG8_BAR;
    }
    for (;;) {
        const bool has_next = S.next(ui + 1, nxt);
        const char* nA = has_next ? (const char*)g.A + (size_t)nxt.pm * tstep : cA; const char* nB = has_next ? (const char*)g.Bt + (size_t)nxt.pn * tstep : cB;
        for (int t = 0; t < nt; t += 2) {
            const bool last = (t == nt - 2);
            const char* a1 = cA + (size_t)(t + 1) * kstep;
            const char* a2 = last ? nA : cA + (size_t)(t + 2) * kstep; const char* b2 = last ? nB : cB + (size_t)(t + 2) * kstep;
            const char* a3 = a2 + kstep; const char* b3 = b2 + kstep;
            if (last && has_next) S.a_ready(nxt);
            if constexpr (Epi::MID) { if (t == Epi::MID_T) E.mid(acc, cur, wr, wc, fr, fq); }
            if constexpr (SP2) {
            PG8_LDB(B0, 0, 0); PG8_LDB(B1, 0, 1); PG8_SCHED; PG8_LDA(At, 0, 0); PG8_STAGE(PG8_SA(1, 1), a1 + hstep, voffA);
            PG8_WAIT_V(8); PG8_WAIT_L(0); PG8_BAR; PG8_MMA(0, 0, At, B0); PG8_MMA(0, 1, At, B1); PG8_BAR; PG8_SCHED;
            PG8_LDA(At, 0, 1); PG8_STAGE(PG8_SB(0, 0), b2, voffB); PG8_STAGE(PG8_SB(0, 1), b2 + hstep, voffB); PG8_STAGE(PG8_SA(0, 0), a2, voffA);
            PG8_WAIT_V(8); PG8_WAIT_L(0); PG8_BAR; PG8_MMA(1, 0, At, B0); PG8_MMA(1, 1, At, B1); PG8_BAR; PG8_SCHED;
            PG8_LDB(B0, 1, 0); PG8_LDB(B1, 1, 1); PG8_SCHED; PG8_LDA(At, 1, 0); PG8_STAGE(PG8_SA(0, 1), a2 + hstep, voffA);
            PG8_WAIT_V(8); PG8_WAIT_L(0); PG8_BAR; PG8_MMA(0, 0, At, B0); PG8_MMA(0, 1, At, B1); PG8_BAR; PG8_SCHED;
            PG8_LDA(At, 1, 1); PG8_STAGE(PG8_SB(1, 0), b3, voffB); PG8_STAGE(PG8_SB(1, 1), b3 + hstep, voffB); PG8_STAGE(PG8_SA(1, 0), a3, voffA);
            PG8_WAIT_V(8); PG8_WAIT_L(0); PG8_BAR; PG8_MMA(1, 0, At, B0); PG8_MMA(1, 1, At, B1); PG8_BAR; PG8_SCHED;
            } else {
            PG8_LDB(B0, 0, 0); PG8_SCHED; PG8_LDA(At, 0, 0); PG8_STAGE(PG8_SA(1, 1), a1 + hstep, voffA);
            PG8_WAIT_L(8); PG8_BAR; PG8_WAIT_L(0); PG8_MMA(0, 0, At, B0); PG8_BAR; PG8_SCHED;
            PG8_LDB(B1, 0, 1); PG8_STAGE(PG8_SB(0, 0), b2, voffB);
            PG8_BAR; PG8_WAIT_L(0); PG8_MMA(0, 1, At, B1); PG8_BAR;
            PG8_LDA(At, 0, 1); PG8_STAGE(PG8_SA(0, 0), a2, voffA);
            PG8_BAR; PG8_WAIT_L(0); PG8_MMA(1, 0, At, B0); PG8_BAR; PG8_SCHED;
            PG8_STAGE(PG8_SB(0, 1), b2 + hstep, voffB);
            PG8_WAIT_V(6); PG8_BAR; PG8_MMA(1, 1, At, B1); PG8_BAR;
            PG8_LDB(B0, 1, 0); PG8_SCHED; PG8_LDA(At, 1, 0); PG8_STAGE(PG8_SA(0, 1), a2 + hstep, voffA);
            PG8_WAIT_L(8); PG8_BAR; PG8_WAIT_L(0); PG8_MMA(0, 0, At, B0); PG8_BAR; PG8_SCHED;
            PG8_LDB(B1, 1, 1); PG8_STAGE(PG8_SB(1, 0), b3, voffB);
            PG8_BAR; PG8_WAIT_L(0); PG8_MMA(0, 1, At, B1); PG8_BAR;
            PG8_LDA(At, 1, 1); PG8_STAGE(PG8_SA(1, 0), a3, voffA);
            PG8_BAR; PG8_WAIT_L(0); PG8_MMA(1, 0, At, B0); PG8_BAR; PG8_SCHED;
            PG8_STAGE(PG8_SB(1, 1), b3 + hstep, voffB);
            PG8_WAIT_V(6); PG8_BAR; PG8_MMA(1, 1, At, B1); PG8_BAR;
            }
        }
        if constexpr (ALIGN_EPI) { if (wr == 0) PG8_BAR; }
        if constexpr (!Epi::AFTER_DRAIN) { E(acc, cur, wr, wc, fr, fq); S.done(cur); }
        if (!has_next) break;
#pragma unroll
        for (int a = 0; a < 2; ++a)
#pragma unroll
            for (int b = 0; b < 2; ++b)
#pragma unroll
                for (int m = 0; m < 4; ++m)
#pragma unroll
                    for (int n = 0; n < 2; ++n) acc[a][b][m][n] = (f32x4){0.f, 0.f, 0.f, 0.f};
        cur = nxt; cA = nA; cB = nB; ++ui;
        if constexpr (ALIGN_EPI) { if (wr == 1) PG8_BAR; }
    }
    PG8_WAIT_V(0);
    if constexpr (!ALIGN_EPI) { if (wr == 0) PG8_BAR; }
    PG8_BAR;
    if constexpr (Epi::AFTER_DRAIN) { E.fused(acc, cur, wr, wc, fr, fq, lds, wid, lane); S.done(cur); }
#undef PG8_SA
#undef PG8_SB
#undef PG8_STAGE
#undef PG8_LDA
#undef PG8_LDB
#undef PG8_MMA
#undef PG8_WAIT_V
#undef PG8_WAIT_L
#undef PG8_BAR
#undef PG8_SCHED
}
}

constexpr int NWAVES = 8;
constexpr int BATCH = 8, SEQ = 4096, D = 1024, DEPTH = 2, M = BATCH * SEQ, IN_COLS = 2304, FF = 2816, GU = 2 * FF;
constexpr float EPS = 1e-6f, LOG2E = 1.4426950408889634f, C2 = 0.125f * LOG2E;
constexpr int NPHASE = 12;
#ifndef MK_DUP
#define MK_DUP -1
#endif
#ifndef MK_ONE_LAUNCH
#define MK_ONE_LAUNCH 0
#endif
constexpr size_t MiB = 1u << 20;
constexpr size_t WS_CTL = 0, CTL_ZERO_BYTES = 1 * MiB;
constexpr size_t WS_SS_MIX = 2 * MiB, WS_SSY = 4 * MiB, WS_SS_FFN = 6 * MiB;
constexpr size_t WS_RS = 1 * MiB;
constexpr size_t WS_W = 8 * MiB, W_LAYER = 23 * MiB, W_IN = 0, W_OUT = 9 * MiB / 2, W_GU = 13 * MiB / 2, W_DOWN = 35 * MiB / 2;
constexpr size_t WS_ATT = 56 * MiB;
constexpr size_t WS_XB = 96 * MiB, WS_PROJ = 160 * MiB, WS_Y = 304 * MiB, WS_ACT = 160 * MiB, WS_END = 368 * MiB;
constexpr int CW_BAR = 4096;
constexpr int RING_OFF = 0, RING_BYTES = 131072;
constexpr int LDSCTL_OFF = RING_BYTES, MISC_OFF = LDSCTL_OFF + 320;
constexpr int LDS_BYTES = 147456;
#define GAS __attribute__((address_space(1)))
#define LAS __attribute__((address_space(3)))
typedef unsigned short bf16;
typedef unsigned v4u __attribute__((ext_vector_type(4)));
typedef float f32x4 __attribute__((ext_vector_type(4)));
typedef short bf16x8 __attribute__((ext_vector_type(8)));
typedef GAS unsigned gu32;
typedef GAS unsigned long long gu64;
#define RLX_AGENT __ATOMIC_RELAXED, __HIP_MEMORY_SCOPE_AGENT
#define LDS_WAIT() asm volatile("s_waitcnt lgkmcnt(0)" ::: "memory")
#define VM_WAIT() asm volatile("s_waitcnt vmcnt(0)" ::: "memory")
__device__ __forceinline__ unsigned long long rt() { return __builtin_amdgcn_s_memrealtime(); }
__device__ __forceinline__ unsigned f2bf(float f) { unsigned u = __builtin_bit_cast(unsigned, f); return (u + 0x7fffu + ((u >> 16) & 1u)) >> 16; }
__device__ __forceinline__ unsigned pk2(float lo, float hi) { return f2bf(lo) | (f2bf(hi) << 16); }

#define XB_TMO      128
#define XB_XCNT(j)  (256  + 64 * (j))
#define XB_XSUB(j)  (1280 + 64 * (j))
#define XB_XGEN(j)  (2304 + 64 * (j))
#define XB_TOP      3328
#define XB_TOPGEN   3392
#define XCD_BAR_WORDS 3456
#define XB_SPIN_CAP (1u << 18)

__device__ __forceinline__ unsigned xb_ld(unsigned* p)              { return __hip_atomic_load(p, __ATOMIC_RELAXED, __HIP_MEMORY_SCOPE_AGENT); }
__device__ __forceinline__ unsigned xb_add(unsigned* p, unsigned v) { return __hip_atomic_fetch_add(p, v, __ATOMIC_RELAXED, __HIP_MEMORY_SCOPE_AGENT); }
__device__ __forceinline__ unsigned xb_xcc_id() { return (unsigned)__builtin_amdgcn_s_getreg((3 << 11) | 20) & 0xFu; }
#define XB_SPIN(cond, bar) do { unsigned _sp = 0; while (cond) { __builtin_amdgcn_s_sleep(1); \
    if ((++_sp & 255u) == 0u) { if (xb_ld(&(bar)[XB_TMO])) break; if (_sp > XB_SPIN_CAP) { atomicAdd(&(bar)[XB_TMO], 1u); break; } } } } while (0)

struct XcdBarrier {
    unsigned* bar; unsigned x;
    volatile LAS unsigned* st;
};

__device__ __forceinline__ XcdBarrier xcd_barrier_post(unsigned* bar, volatile LAS unsigned* st) {
    XcdBarrier b; b.bar = bar; b.x = xb_xcc_id(); b.st = st;
    if (threadIdx.x == 0) (void)xb_add(&bar[XB_XCNT(b.x)], 1u);
    return b;
}
__device__ __forceinline__ void xcd_barrier_complete(unsigned* bar, unsigned x, unsigned& nloc, unsigned& nx) {
    const unsigned G = gridDim.x * gridDim.y * gridDim.z;
    unsigned sum, cnt, mine, sp = 0u;
    for (;;) {
        sum = 0u; cnt = 0u; mine = 0u;
#pragma unroll
        for (unsigned j = 0; j < 16; ++j) { const unsigned c = xb_ld(&bar[XB_XCNT(j)]); sum += c; cnt += (c > 0u) ? 1u : 0u; mine = (j == x) ? c : mine; }
        if (sum == G) break;
        __builtin_amdgcn_s_sleep(1);
        if ((++sp & 255u) == 0u) { if (xb_ld(&bar[XB_TMO])) break; if (sp > XB_SPIN_CAP) { atomicAdd(&bar[XB_TMO], 1u); break; } }
    }
    nloc = mine > 0u ? mine : 1u; nx = cnt > 0u ? cnt : 1u;
}

__device__ __forceinline__ void xcd_barrier(const XcdBarrier& b) {
    asm volatile("s_waitcnt vmcnt(0)" ::: "memory");
    __syncthreads();
    if (threadIdx.x == 0) {
        unsigned* bar = b.bar;
        __builtin_amdgcn_s_waitcnt(0);
        unsigned nloc = b.st[0], nx = b.st[1];
        if (nloc == 0u) { xcd_barrier_complete(bar, b.x, nloc, nx); b.st[0] = nloc; b.st[1] = nx; }
        const unsigned old = xb_add(&bar[XB_XSUB(b.x)], 1u);
        const unsigned gen = old / nloc;
        if (old + 1u == (gen + 1u) * nloc) {
            __builtin_amdgcn_fence(__ATOMIC_RELEASE, "agent");
            asm volatile("s_waitcnt vmcnt(0)" ::: "memory");
            const unsigned og = xb_add(&bar[XB_TOP], 1u);
            const unsigned tg = og / nx;
            if (og + 1u == (tg + 1u) * nx) xb_add(&bar[XB_TOPGEN], 1u);
            else XB_SPIN(xb_ld(&bar[XB_TOPGEN]) == tg, bar);
            __builtin_amdgcn_fence(__ATOMIC_ACQUIRE, "agent");
            xb_add(&bar[XB_XGEN(b.x)], 1u);
            asm volatile("s_waitcnt vmcnt(0)" ::: "memory");
        } else {
            XB_SPIN(xb_ld(&bar[XB_XGEN(b.x)]) == gen, bar);
            __builtin_amdgcn_fence(__ATOMIC_ACQUIRE, "agent");
            asm volatile("s_waitcnt vmcnt(0)" ::: "memory");
        }
    }
    __syncthreads();
}

namespace att {
typedef short bf16x8 __attribute__((ext_vector_type(8)));
typedef short s16x4 __attribute__((ext_vector_type(4)));
typedef float f32x16 __attribute__((ext_vector_type(16)));
typedef float f32x4 __attribute__((ext_vector_type(4)));
typedef unsigned u32x4 __attribute__((ext_vector_type(4)));
typedef unsigned u32x2 __attribute__((ext_vector_type(2)));
typedef float f32x2_t __attribute__((ext_vector_type(2))); typedef __bf16 bf16x2_t __attribute__((ext_vector_type(2)));
typedef short v4i16_t __attribute__((ext_vector_type(4)));
#define ATT_LAS __attribute__((address_space(3)))
constexpr int SPAN = 512, ST_BYTES = SPAN * 64 * 4 + SPAN * 8;
__device__ __forceinline__ unsigned cvtpk(float lo, float hi) { f32x2_t v = {lo, hi}; bf16x2_t b = __builtin_convertvector(v, bf16x2_t); return __builtin_bit_cast(unsigned, b); }
__device__ __forceinline__ s16x4 vtr(const ATT_LAS unsigned char* p) { return __builtin_bit_cast(s16x4, __builtin_amdgcn_ds_read_tr16_b64_v4i16((ATT_LAS v4i16_t*)p)); }

template <int SIDE>
__device__ __forceinline__ void block(const unsigned short* pb, int tq0, int dil, int qoff, int koff, int voff, float slope2, float& m, float& l, f32x16& o0, f32x16& o1, ATT_LAS unsigned char* vbuf, int lane) {
    constexpr int NT = (2 * SIDE + 32) / 32, LD = 2304, SEQL = 4096;
    const int u = lane & 31, hi = lane >> 5;
    bf16x8 qf[4];
    { const unsigned short* qp = pb + (size_t)(tq0 + u * dil) * LD + qoff + 8 * hi;
#pragma unroll
      for (int d0 = 0; d0 < 4; ++d0) qf[d0] = *(const bf16x8*)(qp + 16 * d0); }
    int jlo = 0, jhi = NT - 1;
    while (tq0 + dil * (32 * jlo - SIDE) < 0) ++jlo;
    while (tq0 + dil * (32 * jhi - SIDE) >= SEQL) --jhi;
    const int vkey = lane >> 2, vcol = 8 * (lane & 3);
    const ATT_LAS unsigned char* vrd = vbuf + ((lane >> 4) & 1) * 32 + (lane & 3) * 8 + (4 * hi + ((lane & 15) >> 2)) * 64;
    bf16x8 kf[4], kn[4]; u32x4 vr[4];
#define ATT_LOADK(j, dst) do { const unsigned short* kp_ = pb + (size_t)(tq0 + dil * (32 * (j) - SIDE + u)) * LD + koff + 8 * hi; \
        _Pragma("unroll") for (int d0 = 0; d0 < 4; ++d0) dst[d0] = *(const bf16x8*)(kp_ + 16 * d0); } while (0)
#define ATT_LOADV(j) do { _Pragma("unroll") for (int p_ = 0; p_ < 4; ++p_) { \
        const unsigned short* vp_ = pb + (size_t)(tq0 + dil * (32 * (j) - SIDE + 16 * (p_ & 1) + vkey)) * LD + voff + 32 * (p_ >> 1) + vcol; vr[p_] = *(const u32x4*)vp_; } } while (0)
    ATT_LOADK(jlo, kf); ATT_LOADV(jlo);
#pragma unroll
    for (int d0 = 0; d0 < 4; ++d0) kn[d0] = kf[d0];
    for (int j = jlo; j <= jhi; ++j) {
#pragma unroll
        for (int p = 0; p < 4; ++p) *(ATT_LAS u32x4*)(vbuf + p * 1024 + lane * 16) = vr[p];
        if (j < jhi) { ATT_LOADK(j + 1, kn); ATT_LOADV(j + 1); }
        f32x16 S;
#pragma unroll
        for (int r = 0; r < 16; ++r) S[r] = 0.f;
#pragma unroll
        for (int d0 = 0; d0 < 4; ++d0) S = __builtin_amdgcn_mfma_f32_32x32x16_bf16(kf[d0], qf[d0], S, 0, 0, 0);
        const float c0 = (float)(32 * j - SIDE + 4 * hi - u);
        float mx = -1e30f;
#pragma unroll
        for (int r = 0; r < 16; ++r) { const float ad = __builtin_fabsf(c0 + (float)((r & 3) + 8 * (r >> 2))); float s = S[r] - slope2 * ad; s = (ad > (float)SIDE) ? -1e30f : s; S[r] = s; mx = __builtin_fmaxf(mx, s); }
        mx = __builtin_fmaxf(mx, __shfl_xor(mx, 32));
        const float mn = __builtin_fmaxf(m, mx), alpha = __builtin_amdgcn_exp2f(m - mn); m = mn;
        float ps = 0.f;
#pragma unroll
        for (int r = 0; r < 16; ++r) { S[r] = __builtin_amdgcn_exp2f(S[r] - mn); ps += S[r]; }
        l = l * alpha + ps;
        o0 = o0 * alpha; o1 = o1 * alpha;
        u32x4 w0, w1;
        w0[0] = cvtpk(S[0], S[1]); w0[1] = cvtpk(S[2], S[3]); w0[2] = cvtpk(S[4], S[5]); w0[3] = cvtpk(S[6], S[7]);
        w1[0] = cvtpk(S[8], S[9]); w1[1] = cvtpk(S[10], S[11]); w1[2] = cvtpk(S[12], S[13]); w1[3] = cvtpk(S[14], S[15]);
        const bf16x8 pk0 = __builtin_bit_cast(bf16x8, w0), pk1 = __builtin_bit_cast(bf16x8, w1);
        {
            const s16x4 a0 = vtr(vrd), a1 = vtr(vrd + 512), b0 = vtr(vrd + 1024), b1 = vtr(vrd + 1536);
            const s16x4 c0_ = vtr(vrd + 2048), c1 = vtr(vrd + 2560), d0_ = vtr(vrd + 3072), d1 = vtr(vrd + 3584);
            const bf16x8 v00 = __builtin_shufflevector(a0, a1, 0, 1, 2, 3, 4, 5, 6, 7), v01 = __builtin_shufflevector(b0, b1, 0, 1, 2, 3, 4, 5, 6, 7);
            const bf16x8 v10 = __builtin_shufflevector(c0_, c1, 0, 1, 2, 3, 4, 5, 6, 7), v11 = __builtin_shufflevector(d0_, d1, 0, 1, 2, 3, 4, 5, 6, 7);
            o0 = __builtin_amdgcn_mfma_f32_32x32x16_bf16(v00, pk0, o0, 0, 0, 0); o0 = __builtin_amdgcn_mfma_f32_32x32x16_bf16(v01, pk1, o0, 0, 0, 0);
            o1 = __builtin_amdgcn_mfma_f32_32x32x16_bf16(v10, pk0, o1, 0, 0, 0); o1 = __builtin_amdgcn_mfma_f32_32x32x16_bf16(v11, pk1, o1, 0, 0, 0);
        }
#pragma unroll
        for (int d0 = 0; d0 < 4; ++d0) kf[d0] = kn[d0];
    }
#undef ATT_LOADK
#undef ATT_LOADV
}
__device__ __forceinline__ void finish(float l, const f32x16& o0, const f32x16& o1, unsigned short* yrow, float* ssyp, int hi) {
    const float lt = l + __shfl_xor(l, 32), inv = 1.0f / lt; float sq = 0.f;
#pragma unroll
    for (int g = 0; g < 4; ++g) {
        const float a0 = o0[4 * g] * inv, a1 = o0[4 * g + 1] * inv, a2 = o0[4 * g + 2] * inv, a3 = o0[4 * g + 3] * inv;
        const float b0 = o1[4 * g] * inv, b1 = o1[4 * g + 1] * inv, b2 = o1[4 * g + 2] * inv, b3 = o1[4 * g + 3] * inv;
        sq += ((a0 * a0 + a1 * a1) + (a2 * a2 + a3 * a3)) + ((b0 * b0 + b1 * b1) + (b2 * b2 + b3 * b3));
        u32x2 wa, wb; wa[0] = cvtpk(a0, a1); wa[1] = cvtpk(a2, a3); wb[0] = cvtpk(b0, b1); wb[1] = cvtpk(b2, b3);
        *(u32x2*)(yrow + 8 * g + 4 * hi) = wa; *(u32x2*)(yrow + 32 + 8 * g + 4 * hi) = wb;
    }
    sq += __shfl_xor(sq, 32);
    if (hi == 0) *ssyp = sq;
}
__device__ __forceinline__ void phase(const unsigned short* proj, const float* sink, unsigned short* Y, float* SSY, unsigned char* state_ws, ATT_LAS unsigned char* lds, int vcu, int G) {
    constexpr int LD = 2304, SEQL = 4096, NB = 8, NITEM = 2 * NB * 8 * (SEQL / SPAN);
    int tid_ = threadIdx.x; asm volatile("" : "+v"(tid_));
    const int lane = tid_ & 63, wave = __builtin_amdgcn_readfirstlane(tid_ >> 6), u = lane & 31, hi = lane >> 5;
    ATT_LAS unsigned char* vbuf = lds + wave * 4096;
    float* stO = (float*)(state_ws + (size_t)blockIdx.x * ST_BYTES); float* stML = stO + SPAN * 64;
    for (int it = vcu; it < NITEM; it += G) {
        const bool dg = it < NITEM / 2; const int id = dg ? it : it - NITEM / 2;
        const int span = id & 7, h = (id >> 3) & 7, b = id >> 6, tok0 = span * SPAN, h16 = dg ? h : 8 + h;
        const unsigned short* pb = proj + (size_t)b * SEQL * LD;
        const float slope = __builtin_amdgcn_exp2f(-0.5f * (float)((dg ? 8 + h : h) + 1)) * 1.4426950408889634f;
        if (dg) {
            const int qoff = h * 64, koff = 512 + h * 64, voff = 1024 + h * 64;
#pragma unroll 1
            for (int pass = 0; pass < 3; ++pass) {
                const int dil = pass == 0 ? 16 : (pass == 1 ? 4 : 1);
#pragma unroll 1
                for (int k = 0; k < 2; ++k) {
                    const int bi = wave + 8 * k;
                    const int tq0 = tok0 + (pass == 0 ? bi : (pass == 1 ? 128 * (bi >> 2) + (bi & 3) : 32 * bi));
                    const int ts = tq0 - tok0 + u * dil;
                    float m, l; f32x16 o0, o1;
                    if (pass == 0) { m = -1e30f; l = 0.f;
#pragma unroll
                        for (int r = 0; r < 16; ++r) { o0[r] = 0.f; o1[r] = 0.f; } }
                    else { const f32x2_t ml = *(const f32x2_t*)(stML + 2 * ts); m = ml[0]; l = hi == 0 ? ml[1] : 0.f;
#pragma unroll
                        for (int g = 0; g < 4; ++g) { const f32x4 a = *(const f32x4*)(stO + ts * 64 + 8 * g + 4 * hi), c = *(const f32x4*)(stO + ts * 64 + 32 + 8 * g + 4 * hi);
                            o0[4 * g] = a[0]; o0[4 * g + 1] = a[1]; o0[4 * g + 2] = a[2]; o0[4 * g + 3] = a[3]; o1[4 * g] = c[0]; o1[4 * g + 1] = c[1]; o1[4 * g + 2] = c[2]; o1[4 * g + 3] = c[3]; } }
                    block<64>(pb, tq0, dil, qoff, koff, voff, slope * (float)dil, m, l, o0, o1, vbuf, lane);
                    if (pass < 2) { const float lt = l + __shfl_xor(l, 32);
                        if (hi == 0) { f32x2_t ml; ml[0] = m; ml[1] = lt; *(f32x2_t*)(stML + 2 * ts) = ml; }
#pragma unroll
                        for (int g = 0; g < 4; ++g) { f32x4 a, c; a[0] = o0[4 * g]; a[1] = o0[4 * g + 1]; a[2] = o0[4 * g + 2]; a[3] = o0[4 * g + 3]; c[0] = o1[4 * g]; c[1] = o1[4 * g + 1]; c[2] = o1[4 * g + 2]; c[3] = o1[4 * g + 3];
                            *(f32x4*)(stO + ts * 64 + 8 * g + 4 * hi) = a; *(f32x4*)(stO + ts * 64 + 32 + 8 * g + 4 * hi) = c; } }
                    else { const size_t tok = (size_t)b * SEQL + tq0 + u; finish(l, o0, o1, Y + tok * 1024 + h16 * 64, SSY + tok * 16 + h16, hi); }
                }
                __syncthreads();
            }
        } else {
            const int qoff = 1536 + h * 64, koff = 2048 + (h >> 2) * 64, voff = 2176 + (h >> 2) * 64;
            const float sk2 = sink[h] * 1.4426950408889634f;
#pragma unroll 1
            for (int k = 0; k < 2; ++k) {
                const int tq0 = tok0 + 32 * (wave + 8 * k);
                float m = sk2, l = hi == 0 ? 1.0f : 0.f; f32x16 o0, o1;
#pragma unroll
                for (int r = 0; r < 16; ++r) { o0[r] = 0.f; o1[r] = 0.f; }
                block<128>(pb, tq0, 1, qoff, koff, voff, slope, m, l, o0, o1, vbuf, lane);
                const size_t tok = (size_t)b * SEQL + tq0 + u; finish(l, o0, o1, Y + tok * 1024 + h16 * 64, SSY + tok * 16 + h16, hi);
            }
        }
    }
    __syncthreads();
}
#undef ATT_LAS
}

struct Frame {
    LAS unsigned char* lds;
    volatile LAS unsigned* MISC;
    gu32* ctl;
    int tid, lane, wave;
    int vcu, G;
};
__device__ __forceinline__ float wave_sum(float v) {
#pragma unroll
    for (int o = 1; o < 64; o <<= 1) v += __shfl_xor(v, o);
    return v;
}
__device__ __forceinline__ void p0_item(const float* W, int K, int N, bf16* WT, int out_row0, const float* gk, float nscale, LAS float* scr, int k0, int n0, int lane) {
#pragma unroll 8
    for (int i = 0; i < 32; ++i) { const int kk = 2 * i + (lane >> 5); const float g = gk ? gk[k0 + kk] : 1.0f; scr[kk * 33 + (lane & 31)] = W[(size_t)(k0 + kk) * N + n0 + (lane & 31)] * (g * nscale); }
    LDS_WAIT(); asm volatile("" ::: "memory");
    const int c = lane & 7;
#pragma unroll
    for (int j = 0; j < 4; ++j) { const int n = (lane >> 3) + 8 * j; const LAS float* s = scr + (8 * c) * 33 + n;
        v4u o; o.x = pk2(s[0 * 33], s[1 * 33]); o.y = pk2(s[2 * 33], s[3 * 33]); o.z = pk2(s[4 * 33], s[5 * 33]); o.w = pk2(s[6 * 33], s[7 * 33]);
        *(GAS v4u*)(WT + (size_t)(out_row0 + n) * K + k0 + 8 * c) = o; }
    LDS_WAIT(); asm volatile("" ::: "memory");
}
struct Ptrs {
    const float *x, *g_mix, *w_in, *g_out_dil, *g_out_win, *sink, *w_out, *g_ffn, *w_gate, *w_up, *w_down, *g_final;
    float* out; unsigned char* ws;
};
__device__ __forceinline__ void p0_prologue(Frame& F, const Ptrs& P) {
    LAS float* scr = (LAS float*)(F.lds + RING_OFF + F.wave * 16384);
    const int gw = F.vcu * NWAVES + F.wave, NGW = F.G * NWAVES;
    constexpr int I_IN = (D / 64) * (IN_COLS / 32), I_OUT = (D / 64) * (D / 32), I_G = (D / 64) * (FF / 32), I_D = (FF / 64) * (D / 32);
    constexpr int I_LAYER = I_IN + I_OUT + 2 * I_G + I_D;
    for (int it = gw; it < DEPTH * I_LAYER; it += NGW) {
        const int L = it / I_LAYER; int r = it % I_LAYER;
        bf16* wl = (bf16*)(P.ws + WS_W + (size_t)L * W_LAYER);
        if (r < I_IN) { const int nblk = IN_COLS / 32, kb = r / nblk, nb = r % nblk, n0 = 32 * nb; const bool isq = (n0 < 512) || (n0 >= 1536 && n0 < 2048);
            p0_item(P.w_in + (size_t)L * D * IN_COLS, D, IN_COLS, (bf16*)((unsigned char*)wl + W_IN), n0, P.g_mix + L * D, isq ? C2 : 1.0f, scr, 64 * kb, n0, F.lane); continue; } r -= I_IN;
        if (r < I_OUT) { const int nblk = D / 32, kb = r / nblk, nb = r % nblk, n0 = 32 * nb, k0 = 64 * kb;
            const float* gk = (k0 < 512) ? (P.g_out_dil + L * 512) : (P.g_out_win + L * 512 - 512);
            p0_item(P.w_out + (size_t)L * D * D, D, D, (bf16*)((unsigned char*)wl + W_OUT), n0, gk, 1.0f, scr, k0, n0, F.lane); continue; } r -= I_OUT;
        if (r < 2 * I_G) { const bool up = r >= I_G; if (up) r -= I_G; const int nblk = FF / 32, kb = r / nblk, nb = r % nblk, n0 = 32 * nb;
            const int orow = 256 * (n0 / 128) + (up ? 128 : 0) + (n0 % 128);
            p0_item((up ? P.w_up : P.w_gate) + (size_t)L * D * FF, D, FF, (bf16*)((unsigned char*)wl + W_GU), orow, P.g_ffn + L * D, 1.0f, scr, 64 * kb, n0, F.lane); continue; } r -= 2 * I_G;
        { const int nblk = D / 32, kb = r / nblk, nb = r % nblk, n0 = 32 * nb;
            p0_item(P.w_down + (size_t)L * FF * D, FF, D, (bf16*)((unsigned char*)wl + W_DOWN), n0, nullptr, 1.0f, scr, 64 * kb, n0, F.lane); }
    }
    bf16* XB = (bf16*)(P.ws + WS_XB); float* ss = (float*)(P.ws + WS_SS_MIX);
    for (int m = gw; m < M; m += NGW) {
        const GAS f32x4* xr = (const GAS f32x4*)(P.x + (size_t)m * D) + F.lane;
        f32x4 v[4]; float s = 0.f;
#pragma unroll
        for (int j = 0; j < 4; ++j) { v[j] = xr[64 * j]; s += (v[j].x * v[j].x + v[j].y * v[j].y) + (v[j].z * v[j].z + v[j].w * v[j].w); }
        s = wave_sum(s);
        GAS unsigned long long* o8 = (GAS unsigned long long*)(XB + (size_t)m * D) + F.lane;
#pragma unroll
        for (int j = 0; j < 4; ++j) o8[64 * j] = (unsigned long long)pk2(v[j].x, v[j].y) | ((unsigned long long)pk2(v[j].z, v[j].w) << 32);
        if (F.lane < 16) ss[(size_t)m * 16 + F.lane] = (F.lane == 0) ? s : 0.f;
    }
}
__device__ __forceinline__ void final_norm(Frame& F, const Ptrs& P) {
    const int gw = F.vcu * NWAVES + F.wave, NGW = F.G * NWAVES; const float* ss = (const float*)(P.ws + WS_SS_MIX); const bf16* XB = (const bf16*)(P.ws + WS_XB);
    f32x4 g[4];
#pragma unroll
    for (int j = 0; j < 4; ++j) g[j] = ((const GAS f32x4*)P.g_final)[F.lane + 64 * j];
    for (int m = gw; m < M; m += NGW) {
        const GAS unsigned long long* xr = (const GAS unsigned long long*)(XB + (size_t)m * D) + F.lane;
        GAS f32x4* orow = (GAS f32x4*)(P.out + (size_t)m * D) + F.lane;
        const float rs = __builtin_amdgcn_rsqf(pg8::ss_row_sum(ss, m) * (1.0f / 1024.0f) + EPS);
#pragma unroll
        for (int j = 0; j < 4; ++j) { const unsigned long long w = xr[64 * j]; const unsigned lo = (unsigned)w, hi = (unsigned)(w >> 32);
            f32x4 v; v.x = __uint_as_float(lo << 16); v.y = __uint_as_float(lo & 0xffff0000u); v.z = __uint_as_float(hi << 16); v.w = __uint_as_float(hi & 0xffff0000u);
            orow[64 * j] = v * rs * g[j]; }
    }
}
template <int MODE> __device__ __forceinline__ void rs_prepass(const pg8::StaticOrder& S, const float* ss, float* tab, int tid) {
    pg8::Unit u;
    for (int i = 0; S.next(i, u); ++i)
        for (int r = tid; r < 256; r += NWAVES * 64) { const int row = u.pm * 256 + r;
            const f32x4* p = (const f32x4*)(ss + (size_t)row * 16); const f32x4 a = p[0], b = p[1], c = p[2], d = p[3];
            const float s0 = ((a[0] + a[1]) + (a[2] + a[3])) + ((b[0] + b[1]) + (b[2] + b[3])), s1 = ((c[0] + c[1]) + (c[2] + c[3])) + ((d[0] + d[1]) + (d[2] + d[3]));
            if (MODE == 0) tab[row] = __builtin_amdgcn_rsqf((s0 + s1) * (1.0f / 1024.0f) + EPS);
            else { const float ra = __builtin_amdgcn_rsqf(s0 * (1.0f / 512.0f) + EPS), rb = __builtin_amdgcn_rsqf(s1 * (1.0f / 512.0f) + EPS); pg8::f32x2 v; v[0] = ra * __builtin_amdgcn_rcpf(rb); v[1] = rb; ((pg8::f32x2*)tab)[row] = v; } }
    __syncthreads();
}

struct Args { const float* in[12]; float* out; unsigned char* ws; int ph_lo, ph_hi, li, pad; };
__global__ void __launch_bounds__(NWAVES * 64, 2) mk_fwd(Args args) {
    extern __shared__ __attribute__((aligned(16))) unsigned char lds[];
    Frame F;
    F.lds = (LAS unsigned char*)lds;
    F.MISC = (volatile LAS unsigned*)(F.lds + MISC_OFF);
    F.tid = threadIdx.x; F.lane = F.tid & 63; F.wave = __builtin_amdgcn_readfirstlane(F.tid >> 6);
    F.G = gridDim.x; { const int bx = blockIdx.x; F.vcu = (F.G % 8 == 0) ? (bx % 8) * (F.G / 8) + bx / 8 : bx; }
    unsigned char* ws = args.ws;
    F.ctl = (gu32*)(ws + WS_CTL);
    Ptrs P; P.x = args.in[0]; P.g_mix = args.in[1]; P.w_in = args.in[2]; P.g_out_dil = args.in[3]; P.g_out_win = args.in[4]; P.sink = args.in[5]; P.w_out = args.in[6];
    P.g_ffn = args.in[7]; P.w_gate = args.in[8]; P.w_up = args.in[9]; P.w_down = args.in[10]; P.g_final = args.in[11]; P.out = args.out; P.ws = ws;
    for (int u = F.tid; u < (LDS_BYTES - LDSCTL_OFF) / 4; u += NWAVES * 64) ((LAS unsigned*)(F.lds + LDSCTL_OFF))[u] = 0u;
    __syncthreads();
    XcdBarrier bar; bar.bar = (unsigned*)(F.ctl + CW_BAR); bar.x = 0; bar.st = nullptr;
    if (MK_ONE_LAUNCH) bar = xcd_barrier_post((unsigned*)(F.ctl + CW_BAR), F.MISC + 8);
    const int lo = args.ph_lo, hi = args.ph_hi;
#define IN(k) (lo <= (k) && (k) < hi)
#define SEAM(k) do { if (MK_ONE_LAUNCH && IN(k) && IN((k) + 1)) xcd_barrier(bar); } while (0)
    bf16* XB = (bf16*)(ws + WS_XB); bf16* PROJ = (bf16*)(ws + WS_PROJ); bf16* Y = (bf16*)(ws + WS_Y); bf16* ACT = (bf16*)(ws + WS_ACT);
    float* SS_MIX = (float*)(ws + WS_SS_MIX); float* SSY = (float*)(ws + WS_SSY); float* SS_FFN = (float*)(ws + WS_SS_FFN); float* RS = (float*)(ws + WS_RS);

    if (IN(0)) { p0_prologue(F, P); if (MK_DUP == 9) p0_prologue(F, P); } SEAM(0);
    for (int L = 0; L < DEPTH; ++L) {
        const int pb = 1 + 5 * L;
        const unsigned char* wl = ws + WS_W + (size_t)L * W_LAYER;
        for (int rep_ = 0; rep_ < (MK_DUP == 0 ? 2 : 1); ++rep_)
        if (IN(pb)) {
            pg8::Gemm g{XB, (const bf16*)(wl + W_IN), M, IN_COLS, D}; pg8::StaticOrder S; S.init(M, IN_COLS, F.G, (int)blockIdx.x);
            rs_prepass<0>(S, SS_MIX, RS, F.tid); pg8::EpiProj E{PROJ, IN_COLS, RS};
            pg8::gemm_phase<pg8::EpiProj, pg8::StaticOrder, true, true>(F.lds + RING_OFF, g, S, E);
        } SEAM(pb);
        for (int rep_ = 0; rep_ < (MK_DUP == 1 ? 2 : 1); ++rep_)
        if (IN(pb + 1)) { att::phase(PROJ, P.sink + L * 8, Y, SSY, ws + WS_ATT, F.lds + RING_OFF, F.vcu, F.G); } SEAM(pb + 1);
        for (int rep_ = 0; rep_ < ((MK_DUP == 2 && L == 0) ? 2 : 1); ++rep_)
        if (IN(pb + 2)) {
            pg8::Gemm g{Y, (const bf16*)(wl + W_OUT), M, D, D}; pg8::StaticOrder S; S.init(M, D, F.G, (int)blockIdx.x);
            rs_prepass<1>(S, SSY, RS, F.tid); pg8::EpiRes<true> E{XB, SS_FFN, (const pg8::f32x2*)RS};
            pg8::gemm_phase<pg8::EpiRes<true>, pg8::StaticOrder, true, true>(F.lds + RING_OFF, g, S, E);
        } SEAM(pb + 2);
        for (int rep_ = 0; rep_ < (MK_DUP == 3 ? 2 : 1); ++rep_)
        if (IN(pb + 3)) {
            pg8::Gemm g{XB, (const bf16*)(wl + W_GU), M, GU, D}; pg8::StaticOrder S; S.init(M, GU, F.G, (int)blockIdx.x);
            rs_prepass<0>(S, SS_FFN, RS, F.tid); pg8::EpiSwiglu E{ACT, FF, RS};
            pg8::gemm_phase<pg8::EpiSwiglu, pg8::StaticOrder, true, true>(F.lds + RING_OFF, g, S, E);
        } SEAM(pb + 3);
        if (IN(pb + 4)) {
            pg8::Gemm g{ACT, (const bf16*)(wl + W_DOWN), M, D, FF}; pg8::StaticOrder S; S.init(M, D, F.G, (int)blockIdx.x);
            pg8::EpiRes<false> E{XB, SS_MIX, nullptr};
            pg8::gemm_phase<pg8::EpiRes<false>, pg8::StaticOrder, true, true>(F.lds + RING_OFF, g, S, E);
        } SEAM(pb + 4);
    }
    if (IN(11)) { final_norm(F, P); }
#undef IN
#undef SEAM
}

extern "C" void kernel_launch(void* const* d_in, const int* in_sizes, int n_in, void* d_out, int out_size, void* d_ws, size_t ws_size, hipStream_t stream) {
    static int grid = 0;
    if (grid == 0) {
        if (n_in != 12 || in_sizes[0] != M * D || out_size != M * D || ws_size < WS_END) { fprintf(stderr, "kernel_launch: unexpected sizes (n_in %d, in0 %d, out %d, ws %zu); nothing launched\n", n_in, n_in > 0 ? in_sizes[0] : -1, out_size, ws_size); grid = -1; return; }
        int dev = 0, cus = 0, per_cu = 0;
        if (hipGetDevice(&dev) != hipSuccess || hipDeviceGetAttribute(&cus, hipDeviceAttributeMultiprocessorCount, dev) != hipSuccess) { fprintf(stderr, "kernel_launch: device query failed\n"); grid = -1; return; }
        if (hipFuncSetAttribute((const void*)mk_fwd, hipFuncAttributeMaxDynamicSharedMemorySize, LDS_BYTES) != hipSuccess) { fprintf(stderr, "kernel_launch: hipFuncSetAttribute failed\n"); grid = -1; return; }
        if (hipOccupancyMaxActiveBlocksPerMultiprocessor(&per_cu, (const void*)mk_fwd, NWAVES * 64, LDS_BYTES) != hipSuccess || per_cu < 1) { fprintf(stderr, "kernel_launch: occupancy query reports %d workgroups per CU\n", per_cu); (void)hipGetLastError(); grid = -1; return; }
        grid = cus;
    }
    if (grid < 0) return;
    if (hipMemsetAsync((char*)d_ws + WS_CTL, 0, CTL_ZERO_BYTES, stream) != hipSuccess) { fprintf(stderr, "kernel_launch: memset failed\n"); return; }
    Args a{};
    for (int i = 0; i < 12; ++i) a.in[i] = (const float*)d_in[i];
    a.out = (float*)d_out; a.ws = (unsigned char*)d_ws;
#if MK_ONE_LAUNCH
    a.ph_lo = 0; a.ph_hi = NPHASE; a.li = 0;
    hipLaunchKernelGGL(mk_fwd, dim3(grid), dim3(NWAVES * 64), LDS_BYTES, stream, a);
#else
    for (int p = 0; p < NPHASE; ++p) { a.ph_lo = p; a.ph_hi = p + 1; a.li = p; hipLaunchKernelGGL(mk_fwd, dim3(grid), dim3(NWAVES * 64), LDS_BYTES, stream, a); }
#endif
    const hipError_t le = hipPeekAtLastError();
    if (le != hipSuccess) fprintf(stderr, "kernel_launch: launch failed: %s\n", hipGetErrorName(le));
}
```

```cpp
#define MK_ONE_LAUNCH 1
#include <hip/hip_runtime.h>
#include <cstdio>
#include <cstdint>
namespace pg8 {
#define PG8_LAS __attribute__((address_space(3)))
typedef unsigned short bf16_t;
typedef short bf16x8 __attribute__((ext_vector_type(8)));
typedef float f32x4 __attribute__((ext_vector_type(4)));
typedef unsigned u32x4 __attribute__((ext_vector_type(4)));
constexpr int BM = 256, BK = 64, HALF = 128, HTB = HALF * BK * 2  , STAGE_BYTES = 8 * HTB, NXCD = 8, WGM = 8;

__host__ __device__ __forceinline__ int lds_byte(int r, int c) { const int st = (r >> 4) * 2 + (c >> 5), rr = r & 15, cc = c & 31, ob = rr * 64 + cc * 2; return st * 1024 + (ob ^ (((ob >> 9) & 1) << 5)); }
__host__ __device__ __forceinline__ void stage_rc(int b, int& R, int& C) { const int st = b / 1024, sb = b % 1024, swz = sb ^ (((sb >> 9) & 1) << 5); R = (st >> 1) * 16 + swz / 64; C = (st & 1) * 32 + (swz % 64) / 2; }
__host__ __device__ __forceinline__ int perm32(int rho) { const int n = rho >> 4, i = rho & 15; return 8 * (i >> 2) + 4 * n + (i & 3); }

struct Unit { int pm, pn; };
struct Gemm { const bf16_t* A; const bf16_t* Bt; int M, N, K; };

struct StaticOrder {
    int nM, nN, nwg, G, c;
    __host__ __device__ void init(int M, int N, int G_, int c_) { nM = M / BM; nN = N / BM; nwg = nM * nN; G = G_; c = c_; }
    __host__ __device__ bool next(int i, Unit& u) const {
        const long L = (long)i * G + c; if (L >= nwg) return false;
        int wgid = (int)L; { const int q = nwg / NXCD, r = nwg % NXCD, xcd = wgid % NXCD, off = wgid / NXCD; wgid = (xcd < r ? xcd * (q + 1) : r * (q + 1) + (xcd - r) * q) + off; }
        const int nig = WGM * nN, gid = wgid / nig, fm = gid * WGM, gsz = (nM - fm) < WGM ? (nM - fm) : WGM;
        u.pm = fm + ((wgid % nig) % gsz); u.pn = (wgid % nig) / gsz; return true;
    }
    __device__ __forceinline__ void a_ready(const Unit&) const {}
    __device__ __forceinline__ void done(const Unit&) const {}
};


__device__ __forceinline__ unsigned cvt_pk_bf16(float lo, float hi) { unsigned r; asm volatile("v_cvt_pk_bf16_f32 %0, %1, %2" : "=v"(r) : "v"(lo), "v"(hi)); return r; }
typedef float f32x2 __attribute__((ext_vector_type(2)));
typedef unsigned u32x2 __attribute__((ext_vector_type(2)));
constexpr int NSS = 16;
__device__ __forceinline__ float ss_row_sum(const float* ss, int row) {
    const f32x4* p = (const f32x4*)(ss + (size_t)row * NSS);
    const f32x4 a = p[0], b = p[1], c = p[2], d = p[3];
    return ((a[0] + a[1]) + (a[2] + a[3])) + ((b[0] + b[1]) + (b[2] + b[3])) + ((c[0] + c[1]) + (c[2] + c[3])) + ((d[0] + d[1]) + (d[2] + d[3]));
}
struct EpiProj {
    static constexpr bool PERM = true, AFTER_DRAIN = false, MID = false; static constexpr int MID_T = -1;
    bf16_t* O; int ldc; const float* rs_tab;
    __device__ __forceinline__ void mid(f32x4 (&acc)[2][2][4][2], const Unit& u, int wr, int wc, int fr, int fq) const {}
    __device__ __forceinline__ void operator()(const f32x4 (&acc)[2][2][4][2], const Unit& u, int wr, int wc, int fr, int fq) const {
        const int row0 = u.pm * BM + wr * 64 + fr, col0 = u.pn * BM + wc * 32 + 8 * fq;
        float rsv[2][4];
#pragma unroll
        for (int ai = 0; ai < 2; ++ai)
#pragma unroll
            for (int m = 0; m < 4; ++m) rsv[ai][m] = rs_tab[row0 + ai * HALF + m * 16];
#pragma unroll
        for (int ai = 0; ai < 2; ++ai)
#pragma unroll
            for (int m = 0; m < 4; ++m) { const int row = row0 + ai * HALF + m * 16;
                const float rs = rsv[ai][m];
                bf16_t* rowp = O + (size_t)row * ldc + col0;
#pragma unroll
                for (int bj = 0; bj < 2; ++bj) { const f32x4 v0 = acc[ai][bj][m][0] * rs, v1 = acc[ai][bj][m][1] * rs;
                    u32x4 w; w.x = cvt_pk_bf16(v0[0], v0[1]); w.y = cvt_pk_bf16(v0[2], v0[3]); w.z = cvt_pk_bf16(v1[0], v1[1]); w.w = cvt_pk_bf16(v1[2], v1[3]);
                    *(u32x4*)(rowp + bj * HALF) = w; } }
    }
};
struct EpiSwiglu {
    static constexpr bool PERM = true, AFTER_DRAIN = false, MID = false; static constexpr int MID_T = -1;
    bf16_t* O; int ldc; const float* rs_tab;
    __device__ __forceinline__ void mid(f32x4 (&acc)[2][2][4][2], const Unit& u, int wr, int wc, int fr, int fq) const {}
    __device__ __forceinline__ float act1(float g, float up, float rs) const { const float z = g * rs; return z * __builtin_amdgcn_rcpf(1.0f + __builtin_amdgcn_exp2f(z * -1.4426950408889634f)) * (up * rs); }
    __device__ __forceinline__ void operator()(const f32x4 (&acc)[2][2][4][2], const Unit& u, int wr, int wc, int fr, int fq) const {
        const int row0 = u.pm * BM + wr * 64 + fr, col0 = u.pn * HALF + wc * 32 + 8 * fq;
        float rsv[2][4];
#pragma unroll
        for (int ai = 0; ai < 2; ++ai)
#pragma unroll
            for (int m = 0; m < 4; ++m) rsv[ai][m] = rs_tab[row0 + ai * HALF + m * 16];
#pragma unroll
        for (int ai = 0; ai < 2; ++ai)
#pragma unroll
            for (int m = 0; m < 4; ++m) { const int row = row0 + ai * HALF + m * 16;
                const float rs = rsv[ai][m];
                const f32x4 g0 = acc[ai][0][m][0], g1 = acc[ai][0][m][1], u0 = acc[ai][1][m][0], u1 = acc[ai][1][m][1];
                u32x4 w; w.x = cvt_pk_bf16(act1(g0[0], u0[0], rs), act1(g0[1], u0[1], rs)); w.y = cvt_pk_bf16(act1(g0[2], u0[2], rs), act1(g0[3], u0[3], rs));
                w.z = cvt_pk_bf16(act1(g1[0], u1[0], rs), act1(g1[1], u1[1], rs)); w.w = cvt_pk_bf16(act1(g1[2], u1[2], rs), act1(g1[3], u1[3], rs));
                *(u32x4*)(O + (size_t)row * ldc + col0) = w; }
    }
};
template <bool YSCALE> struct EpiRes {
    static constexpr bool PERM = true, AFTER_DRAIN = false, MID = YSCALE; static constexpr int MID_T = 8;
    bf16_t* xb; float* ssout; const f32x2* ys;
    __device__ __forceinline__ void mid(f32x4 (&acc)[2][2][4][2], const Unit& u, int wr, int wc, int fr, int fq) const {
        if constexpr (YSCALE) {
            const int row0 = u.pm * BM + wr * 64 + fr;
            float fv[2][4];
#pragma unroll
            for (int ai = 0; ai < 2; ++ai)
#pragma unroll
                for (int m = 0; m < 4; ++m) fv[ai][m] = ys[row0 + ai * HALF + m * 16][0];
#pragma unroll
            for (int ai = 0; ai < 2; ++ai)
#pragma unroll
                for (int m = 0; m < 4; ++m)
#pragma unroll
                    for (int bj = 0; bj < 2; ++bj)
#pragma unroll
                        for (int n = 0; n < 2; ++n) acc[ai][bj][m][n] *= fv[ai][m];
        }
    }
    __device__ __forceinline__ void operator()(const f32x4 (&acc)[2][2][4][2], const Unit& u, int wr, int wc, int fr, int fq) const {
        const int row0 = u.pm * BM + wr * 64 + fr, col0 = u.pn * BM + wc * 32 + 8 * fq;
        float fsv[2][4];
#pragma unroll
        for (int ai = 0; ai < 2; ++ai)
#pragma unroll
            for (int m = 0; m < 4; ++m) fsv[ai][m] = YSCALE ? ys[row0 + ai * HALF + m * 16][1] : 1.0f;
#pragma unroll
        for (int ai = 0; ai < 2; ++ai) {
            u32x4 res[4][2];
#pragma unroll
            for (int m = 0; m < 4; ++m)
#pragma unroll
                for (int bj = 0; bj < 2; ++bj) res[m][bj] = *(const u32x4*)(xb + (size_t)(row0 + ai * HALF + m * 16) * 1024 + col0 + bj * HALF);
#pragma unroll
            for (int m = 0; m < 4; ++m) { const int row = row0 + ai * HALF + m * 16; const float fs = fsv[ai][m];
                float q = 0.f;
#pragma unroll
                for (int bj = 0; bj < 2; ++bj) { const u32x4 bb = res[m][bj];
                    f32x4 b0, b1; b0[0] = __uint_as_float(bb[0] << 16); b0[1] = __uint_as_float(bb[0] & 0xffff0000u); b0[2] = __uint_as_float(bb[1] << 16); b0[3] = __uint_as_float(bb[1] & 0xffff0000u);
                    b1[0] = __uint_as_float(bb[2] << 16); b1[1] = __uint_as_float(bb[2] & 0xffff0000u); b1[2] = __uint_as_float(bb[3] << 16); b1[3] = __uint_as_float(bb[3] & 0xffff0000u);
                    const f32x4 o0 = b0 + acc[ai][bj][m][0] * fs, o1 = b1 + acc[ai][bj][m][1] * fs;
                    u32x4 w; w.x = cvt_pk_bf16(o0[0], o0[1]); w.y = cvt_pk_bf16(o0[2], o0[3]); w.z = cvt_pk_bf16(o1[0], o1[1]); w.w = cvt_pk_bf16(o1[2], o1[3]);
                    *(u32x4*)(xb + (size_t)row * 1024 + col0 + bj * HALF) = w;
                    q += ((o0[0] * o0[0] + o0[1] * o0[1]) + (o0[2] * o0[2] + o0[3] * o0[3])) + ((o1[0] * o1[0] + o1[1] * o1[1]) + (o1[2] * o1[2] + o1[3] * o1[3])); }
                q += __shfl_xor(q, 16); q += __shfl_xor(q, 32);
                if (fq == 0) ssout[(size_t)row * NSS + u.pn * 4 + wc] = q; }
            asm volatile("" ::: "memory");
        }
    }
};

template <class Epi, class Sched, bool ALIGN_EPI = false, bool SP2 = false>
__device__ __forceinline__ void gemm_phase(PG8_LAS unsigned char* lds, const Gemm g, const Sched& S, const Epi& E) {
    int tid_ = threadIdx.x; asm volatile("" : "+v"(tid_));
    const int tid = tid_, wid = __builtin_amdgcn_readfirstlane(tid >> 6), lane = tid & 63, wr = wid >> 2, wc = wid & 3, fr = lane & 15, fq = lane >> 4;
    const int K = g.K, nt = K / BK;
    unsigned voffA[2], voffB[2];
#pragma unroll
    for (int i = 0; i < 2; ++i) { int R, C; stage_rc(tid * 16 + i * 8192, R, C); const int Rb = Epi::PERM ? ((R & ~31) + perm32(R & 31)) : R;
        voffA[i] = (unsigned)(R * K + C) * 2u; voffB[i] = (unsigned)(Rb * K + C) * 2u; }
    const size_t kstep = (size_t)(BK * 2);
    const size_t hstep = (size_t)HALF * K * 2;
    const size_t tstep = 2 * hstep;
    const unsigned ldsw = (unsigned)wid * 1024u;
    const int aoff = lds_byte(wr * 64 + fr, fq * 8), boff = lds_byte(wc * 32 + fr, fq * 8);
#define PG8_SA(b, h) (((b) * 2 + (h)) * HTB)
#define PG8_SB(b, h) ((4 + (b) * 2 + (h)) * HTB)
#define PG8_STAGE(bufoff, gbase, voff) do { _Pragma("unroll") for (int _i = 0; _i < 2; ++_i) \
        __builtin_amdgcn_global_load_lds((const unsigned*)((const char*)(gbase) + (voff)[_i]), (PG8_LAS unsigned*)(lds + (bufoff) + ldsw + _i * 8192), 16, 0, 0); } while (0)
#define PG8_LDA(dst, b, h) do { _Pragma("unroll") for (int m = 0; m < 4; ++m) _Pragma("unroll") for (int k = 0; k < 2; ++k) dst[m][k] = *(const PG8_LAS bf16x8*)(lds + PG8_SA(b, h) + aoff + m * 2048 + k * 1024); } while (0)
#define PG8_LDB(dst, b, h) do { _Pragma("unroll") for (int n = 0; n < 2; ++n) _Pragma("unroll") for (int k = 0; k < 2; ++k) dst[n][k] = *(const PG8_LAS bf16x8*)(lds + PG8_SB(b, h) + boff + n * 2048 + k * 1024); } while (0)
#define PG8_MMA(ai, bj, At, Bt) do { __builtin_amdgcn_s_setprio(1); _Pragma("unroll") for (int m = 0; m < 4; ++m) _Pragma("unroll") for (int n = 0; n < 2; ++n) _Pragma("unroll") for (int k = 0; k < 2; ++k) \
        acc[ai][bj][m][n] = __builtin_amdgcn_mfma_f32_16x16x32_bf16(Bt[n][k], At[m][k], acc[ai][bj][m][n], 0, 0, 0); __builtin_amdgcn_s_setprio(0); } while (0)
#define PG8_WAIT_V(n) asm volatile("s_waitcnt vmcnt(" #n ")" ::: "memory")
#define PG8_WAIT_L(n) asm volatile("s_waitcnt lgkmcnt(" #n ")" ::: "memory")
#define PG8_BAR __builtin_amdgcn_s_barrier()
#define PG8_SCHED __builtin_amdgcn_sched_barrier(0)
    Unit cur, nxt; int ui = 0;
    if (!S.next(0, cur)) return;
    f32x4 acc[2][2][4][2];
#pragma unroll
    for (int a = 0; a < 2; ++a)
#pragma unroll
        for (int b = 0; b < 2; ++b)
#pragma unroll
            for (int m = 0; m < 4; ++m)
#pragma unroll
                for (int n = 0; n < 2; ++n) acc[a][b][m][n] = (f32x4){0.f, 0.f, 0.f, 0.f};
    bf16x8 At[4][2], B0[2][2], B1[2][2];
    const char* cA = (const char*)g.A + (size_t)cur.pm * tstep; const char* cB = (const char*)g.Bt + (size_t)cur.pn * tstep;
    S.a_ready(cur);
    if constexpr (SP2) {
        PG8_STAGE(PG8_SB(0, 0), cB, voffB); PG8_STAGE(PG8_SB(0, 1), cB + hstep, voffB); PG8_STAGE(PG8_SA(0, 0), cA, voffA); PG8_STAGE(PG8_SA(0, 1), cA + hstep, voffA);
        if (wr == 1) PG8_BAR;
        PG8_WAIT_V(2); PG8_BAR;
        PG8_STAGE(PG8_SB(1, 0), cB + kstep, voffB); PG8_STAGE(PG8_SA(1, 0), cA + kstep, voffA); PG8_STAGE(PG8_SB(1, 1), cB + hstep + kstep, voffB);
        PG8_WAIT_V(6); PG8_BAR;
    } else {
        PG8_STAGE(PG8_SB(0, 0), cB, voffB); PG8_STAGE(PG8_SA(0, 0), cA, voffA); PG8_STAGE(PG8_SB(0, 1), cB + hstep, voffB); PG8_STAGE(PG8_SA(0, 1), cA + hstep, voffA);
        if (wr == 1) PG8_BAR;
        PG8_WAIT_V(4); PG8_BAR;
        PG8_STAGE(PG8_SB(1, 0), cB + kstep, voffB); PG8_STAGE(PG8_SA(1, 0), cA + kstep, voffA); PG8_STAGE(PG8_SB(1, 1), cB + hstep + kstep, voffB);
        PG8_WAIT_V(6); PG8_BAR;
    }
    for (;;) {
        const bool has_next = S.next(ui + 1, nxt);
        const char* nA = has_next ? (const char*)g.A + (size_t)nxt.pm * tstep : cA; const char* nB = has_next ? (const char*)g.Bt + (size_t)nxt.pn * tstep : cB;
        for (int t = 0; t < nt; t += 2) {
            const bool last = (t == nt - 2);
            const char* a1 = cA + (size_t)(t + 1) * kstep;
            const char* a2 = last ? nA : cA + (size_t)(t + 2) * kstep; const char* b2 = last ? nB : cB + (size_t)(t + 2) * kstep;
            const char* a3 = a2 + kstep; const char* b3 = b2 + kstep;
            if (last && has_next) S.a_ready(nxt);
            if constexpr (Epi::MID) { if (t == Epi::MID_T) E.mid(acc, cur, wr, wc, fr, fq); }
            if constexpr (SP2) {
            PG8_LDB(B0, 0, 0); PG8_LDB(B1, 0, 1); PG8_SCHED; PG8_LDA(At, 0, 0); PG8_STAGE(PG8_SA(1, 1), a1 + hstep, voffA);
            PG8_WAIT_V(8); PG8_WAIT_L(0); PG8_BAR; PG8_MMA(0, 0, At, B0); PG8_MMA(0, 1, At, B1); PG8_BAR; PG8_SCHED;
            PG8_LDA(At, 0, 1); PG8_STAGE(PG8_SB(0, 0), b2, voffB); PG8_STAGE(PG8_SB(0, 1), b2 + hstep, voffB); PG8_STAGE(PG8_SA(0, 0), a2, voffA);
            PG8_WAIT_V(8); PG8_WAIT_L(0); PG8_BAR; PG8_MMA(1, 0, At, B0); PG8_MMA(1, 1, At, B1); PG8_BAR; PG8_SCHED;
            PG8_LDB(B0, 1, 0); PG8_LDB(B1, 1, 1); PG8_SCHED; PG8_LDA(At, 1, 0); PG8_STAGE(PG8_SA(0, 1), a2 + hstep, voffA);
            PG8_WAIT_V(8); PG8_WAIT_L(0); PG8_BAR; PG8_MMA(0, 0, At, B0); PG8_MMA(0, 1, At, B1); PG8_BAR; PG8_SCHED;
            PG8_LDA(At, 1, 1); PG8_STAGE(PG8_SB(1, 0), b3, voffB); PG8_STAGE(PG8_SB(1, 1), b3 + hstep, voffB); PG8_STAGE(PG8_SA(1, 0), a3, voffA);
            PG8_WAIT_V(8); PG8_WAIT_L(0); PG8_BAR; PG8_MMA(1, 0, At, B0); PG8_MMA(1, 1, At, B1); PG8_BAR; PG8_SCHED;
            } else {
            PG8_LDB(B0, 0, 0); PG8_SCHED; PG8_LDA(At, 0, 0); PG8_STAGE(PG8_SA(1, 1), a1 + hstep, voffA);
            PG8_WAIT_L(8); PG8_BAR; PG8_WAIT_L(0); PG8_MMA(0, 0, At, B0); PG8_BAR; PG8_SCHED;
            PG8_LDB(B1, 0, 1); PG8_STAGE(PG8_SB(0, 0), b2, voffB);
            PG8_BAR; PG8_WAIT_L(0); PG8_MMA(0, 1, At, B1); PG8_BAR;
            PG8_LDA(At, 0, 1); PG8_STAGE(PG8_SA(0, 0), a2, voffA);
            PG8_BAR; PG8_WAIT_L(0); PG8_MMA(1, 0, At, B0); PG8_BAR; PG8_SCHED;
            PG8_STAGE(PG8_SB(0, 1), b2 + hstep, voffB);
            PG8_WAIT_V(6); PG8_BAR; PG8_MMA(1, 1, At, B1); PG8_BAR;
            PG8_LDB(B0, 1, 0); PG8_SCHED; PG8_LDA(At, 1, 0); PG8_STAGE(PG8_SA(0, 1), a2 + hstep, voffA);
            PG8_WAIT_L(8); PG8_BAR; PG8_WAIT_L(0); PG8_MMA(0, 0, At, B0); PG8_BAR; PG8_SCHED;
            PG8_LDB(B1, 1, 1); PG8_STAGE(PG8_SB(1, 0), b3, voffB);
            PG8_BAR; PG8_WAIT_L(0); PG8_MMA(0, 1, At, B1); PG8_BAR;
            PG8_LDA(At, 1, 1); PG8_STAGE(PG8_SA(1, 0), a3, voffA);
            PG8_BAR; PG8_WAIT_L(0); PG8_MMA(1, 0, At, B0); PG8_BAR; PG8_SCHED;
            PG8_STAGE(PG8_SB(1, 1), b3 + hstep, voffB);
            PG8_WAIT_V(6); PG8_BAR; PG8_MMA(1, 1, At, B1); PG8_BAR;
            }
        }
        if constexpr (ALIGN_EPI) { if (wr == 0) PG8_BAR; }
        if constexpr (!Epi::AFTER_DRAIN) { E(acc, cur, wr, wc, fr, fq); S.done(cur); }
        if (!has_next) break;
#pragma unroll
        for (int a = 0; a < 2; ++a)
#pragma unroll
            for (int b = 0; b < 2; ++b)
#pragma unroll
                for (int m = 0; m < 4; ++m)
#pragma unroll
                    for (int n = 0; n < 2; ++n) acc[a][b][m][n] = (f32x4){0.f, 0.f, 0.f, 0.f};
        cur = nxt; cA = nA; cB = nB; ++ui;
        if constexpr (ALIGN_EPI) { if (wr == 1) PG8_BAR; }
    }
    PG8_WAIT_V(0);
    if constexpr (!ALIGN_EPI) { if (wr == 0) PG8_BAR; }
    PG8_BAR;
    if constexpr (Epi::AFTER_DRAIN) { E.fused(acc, cur, wr, wc, fr, fq, lds, wid, lane); S.done(cur); }
#undef PG8_SA
#undef PG8_SB
#undef PG8_STAGE
#undef PG8_LDA
#undef PG8_LDB
#undef PG8_MMA
#undef PG8_WAIT_V
#undef PG8_WAIT_L
#undef PG8_BAR
#undef PG8_SCHED
}
}

constexpr int NWAVES = 8;
constexpr int BATCH = 8, SEQ = 4096, D = 1024, DEPTH = 2, M = BATCH * SEQ, IN_COLS = 2304, FF = 2816, GU = 2 * FF;
constexpr float EPS = 1e-6f, LOG2E = 1.4426950408889634f, C2 = 0.125f * LOG2E;
constexpr int NPHASE = 12;
#ifndef TS_SCALE
#define TS_SCALE 0.01f
#endif
#ifndef MK_DUP
#define MK_DUP -1
#endif
#ifndef MK_ONE_LAUNCH
#define MK_ONE_LAUNCH 0
#endif
constexpr size_t MiB = 1u << 20;
constexpr size_t WS_CTL = 0, CTL_ZERO_BYTES = 1 * MiB;
constexpr size_t WS_SS_MIX = 2 * MiB, WS_SSY = 4 * MiB, WS_SS_FFN = 6 * MiB;
constexpr size_t WS_RS = 1 * MiB;
constexpr size_t WS_W = 8 * MiB, W_LAYER = 23 * MiB, W_IN = 0, W_OUT = 9 * MiB / 2, W_GU = 13 * MiB / 2, W_DOWN = 35 * MiB / 2;
constexpr size_t WS_ATT = 368 * MiB;
constexpr size_t WS_XB = 96 * MiB, WS_PROJ = 160 * MiB, WS_Y = 304 * MiB, WS_ACT = 160 * MiB, WS_END = 440 * MiB;
constexpr int CW_BAR = 4096;
constexpr int RING_OFF = 0, RING_BYTES = 131072;
constexpr int LDSCTL_OFF = RING_BYTES, MISC_OFF = LDSCTL_OFF + 320;
constexpr int LDS_BYTES = 147456;
#define GAS __attribute__((address_space(1)))
#define LAS __attribute__((address_space(3)))
typedef unsigned short bf16;
typedef unsigned v4u __attribute__((ext_vector_type(4)));
typedef float f32x4 __attribute__((ext_vector_type(4)));
typedef short bf16x8 __attribute__((ext_vector_type(8)));
typedef GAS unsigned gu32;
typedef GAS unsigned long long gu64;
#define RLX_AGENT __ATOMIC_RELAXED, __HIP_MEMORY_SCOPE_AGENT
#define LDS_WAIT() asm volatile("s_waitcnt lgkmcnt(0)" ::: "memory")
#define VM_WAIT() asm volatile("s_waitcnt vmcnt(0)" ::: "memory")
__device__ __forceinline__ unsigned long long rt() { return __builtin_amdgcn_s_memrealtime(); }
__device__ __forceinline__ unsigned f2bf(float f) { unsigned u = __builtin_bit_cast(unsigned, f); return (u + 0x7fffu + ((u >> 16) & 1u)) >> 16; }
__device__ __forceinline__ unsigned pk2(float lo, float hi) { return f2bf(lo) | (f2bf(hi) << 16); }

#define XB_TMO      128
#define XB_XCNT(j)  (256  + 64 * (j))
#define XB_XSUB(j)  (1280 + 64 * (j))
#define XB_XGEN(j)  (2304 + 64 * (j))
#define XB_TOP      3328
#define XB_TOPGEN   3392
#define XCD_BAR_WORDS 3456
#define XB_SPIN_CAP (1u << 18)

__device__ __forceinline__ unsigned xb_ld(unsigned* p)              { return __hip_atomic_load(p, __ATOMIC_RELAXED, __HIP_MEMORY_SCOPE_AGENT); }
__device__ __forceinline__ unsigned xb_add(unsigned* p, unsigned v) { return __hip_atomic_fetch_add(p, v, __ATOMIC_RELAXED, __HIP_MEMORY_SCOPE_AGENT); }
__device__ __forceinline__ unsigned xb_xcc_id() { return (unsigned)__builtin_amdgcn_s_getreg((3 << 11) | 20) & 0xFu; }
#define XB_SPIN(cond, bar) do { unsigned _sp = 0; while (cond) { __builtin_amdgcn_s_sleep(1); \
    if ((++_sp & 255u) == 0u) { if (xb_ld(&(bar)[XB_TMO])) break; if (_sp > XB_SPIN_CAP) { atomicAdd(&(bar)[XB_TMO], 1u); break; } } } } while (0)

struct XcdBarrier {
    unsigned* bar; unsigned x;
    volatile LAS unsigned* st;
};

__device__ __forceinline__ XcdBarrier xcd_barrier_post(unsigned* bar, volatile LAS unsigned* st) {
    XcdBarrier b; b.bar = bar; b.x = xb_xcc_id(); b.st = st;
    if (threadIdx.x == 0) (void)xb_add(&bar[XB_XCNT(b.x)], 1u);
    return b;
}
__device__ __forceinline__ void xcd_barrier_complete(unsigned* bar, unsigned x, unsigned& nloc, unsigned& nx) {
    const unsigned G = gridDim.x * gridDim.y * gridDim.z;
    unsigned sum, cnt, mine, sp = 0u;
    for (;;) {
        sum = 0u; cnt = 0u; mine = 0u;
#pragma unroll
        for (unsigned j = 0; j < 16; ++j) { const unsigned c = xb_ld(&bar[XB_XCNT(j)]); sum += c; cnt += (c > 0u) ? 1u : 0u; mine = (j == x) ? c : mine; }
        if (sum == G) break;
        __builtin_amdgcn_s_sleep(1);
        if ((++sp & 255u) == 0u) { if (xb_ld(&bar[XB_TMO])) break; if (sp > XB_SPIN_CAP) { atomicAdd(&bar[XB_TMO], 1u); break; } }
    }
    nloc = mine > 0u ? mine : 1u; nx = cnt > 0u ? cnt : 1u;
}

__device__ __forceinline__ void xcd_barrier(const XcdBarrier& b) {
    asm volatile("s_waitcnt vmcnt(0)" ::: "memory");
    __syncthreads();
    if (threadIdx.x == 0) {
        unsigned* bar = b.bar;
        __builtin_amdgcn_s_waitcnt(0);
        unsigned nloc = b.st[0], nx = b.st[1];
        if (nloc == 0u) { xcd_barrier_complete(bar, b.x, nloc, nx); b.st[0] = nloc; b.st[1] = nx; }
        const unsigned old = xb_add(&bar[XB_XSUB(b.x)], 1u);
        const unsigned gen = old / nloc;
        if (old + 1u == (gen + 1u) * nloc) {
            __builtin_amdgcn_fence(__ATOMIC_RELEASE, "agent");
            asm volatile("s_waitcnt vmcnt(0)" ::: "memory");
            const unsigned og = xb_add(&bar[XB_TOP], 1u);
            const unsigned tg = og / nx;
            if (og + 1u == (tg + 1u) * nx) xb_add(&bar[XB_TOPGEN], 1u);
            else XB_SPIN(xb_ld(&bar[XB_TOPGEN]) == tg, bar);
            __builtin_amdgcn_fence(__ATOMIC_ACQUIRE, "agent");
            xb_add(&bar[XB_XGEN(b.x)], 1u);
            asm volatile("s_waitcnt vmcnt(0)" ::: "memory");
        } else {
            XB_SPIN(xb_ld(&bar[XB_XGEN(b.x)]) == gen, bar);
            __builtin_amdgcn_fence(__ATOMIC_ACQUIRE, "agent");
            asm volatile("s_waitcnt vmcnt(0)" ::: "memory");
        }
    }
    __syncthreads();
}

namespace att {
#ifndef TS_PROBE
#define TS_PROBE 0
#endif
#define TS_T0(k) unsigned long long ts0_ = 0; if ((TS_PROBE % 10) == (k) && tson) ts0_ = __builtin_amdgcn_s_memrealtime();
#define TS_T1(k) if ((TS_PROBE % 10) == (k) && tson) tsacc += (float)(__builtin_amdgcn_s_memrealtime() - ts0_);
#ifndef ATT_PROBE
#define ATT_PROBE 0
#endif
typedef short bf16x8 __attribute__((ext_vector_type(8)));
typedef short s16x4 __attribute__((ext_vector_type(4)));
typedef float f32x16 __attribute__((ext_vector_type(16)));
typedef float f32x4 __attribute__((ext_vector_type(4)));
typedef unsigned u32x4 __attribute__((ext_vector_type(4)));
typedef unsigned u32x2 __attribute__((ext_vector_type(2)));
typedef float f32x2_t __attribute__((ext_vector_type(2))); typedef __bf16 bf16x2_t __attribute__((ext_vector_type(2)));
typedef short v4i16_t __attribute__((ext_vector_type(4)));
#define ATT_LAS __attribute__((address_space(3)))
constexpr int SPAN = 1024, ST_BYTES = SPAN * 64 * 4 + SPAN * 8;
constexpr int LD = 2304, SEQL = 4096;
__device__ __forceinline__ unsigned cvtpk(float lo, float hi) { f32x2_t v = {lo, hi}; bf16x2_t b = __builtin_convertvector(v, bf16x2_t); return __builtin_bit_cast(unsigned, b); }
__device__ __forceinline__ s16x4 vtr(const ATT_LAS unsigned char* p) { return __builtin_bit_cast(s16x4, __builtin_amdgcn_ds_read_tr16_b64_v4i16((ATT_LAS v4i16_t*)p)); }
__device__ __forceinline__ void glds16(const void* gsrc, unsigned lds_dst) { unsigned keep;
#if ATT_PROBE == 5
    asm volatile("s_mov_b32 %0, m0\n\ts_mov_b32 m0, %2\n\ts_nop 0\n\tglobal_load_lds_dwordx4 %1, off\n\ts_mov_b32 m0, %0" : "=&s"(keep) : "v"(gsrc), "s"(lds_dst) : "memory");
#endif
    asm volatile("s_mov_b32 %0, m0\n\ts_mov_b32 m0, %2\n\ts_nop 0\n\tglobal_load_lds_dwordx4 %1, off\n\ts_mov_b32 m0, %0" : "=&s"(keep) : "v"(gsrc), "s"(lds_dst) : "memory"); }
#if ATT_PROBE == 5
#define ATT_WAITV(N) asm volatile("s_waitcnt vmcnt(%0)" :: "i"(2 * (N)) : "memory")
#else
#define ATT_WAITV(N) asm volatile("s_waitcnt vmcnt(" #N ")" ::: "memory")
#endif
#define ATT_WAITL() asm volatile("s_waitcnt lgkmcnt(0)" ::: "memory")

template <int K> __device__ __forceinline__ float a_addk(float a) { float r; asm("v_add_f32_e32 %0, %1, %2" : "=v"(r) : "i"(__builtin_bit_cast(int, (float)K)), "v"(a)); return r; }
__device__ __forceinline__ float a_add(float a, float b) { float r; asm("v_add_f32_e32 %0, %1, %2" : "=v"(r) : "v"(a), "v"(b)); return r; }
__device__ __forceinline__ float a_sub(float a, float b) { float r; asm("v_sub_f32_e32 %0, %1, %2" : "=v"(r) : "v"(a), "v"(b)); return r; }
__device__ __forceinline__ float a_fma_nabs(float sl, float x, float c) { float r; asm("v_fma_f32 %0, -%1, |%2|, %3" : "=v"(r) : "v"(sl), "v"(x), "v"(c)); return r; }
__device__ __forceinline__ float swap32max(float v) { auto rr = __builtin_amdgcn_permlane32_swap(__float_as_uint(v), __float_as_uint(v), false, false); return __builtin_fmaxf(__uint_as_float(rr[0]), __uint_as_float(rr[1])); }
constexpr float THR = 8.0f;

template <int SIDE, bool EDGE, int R> __device__ __forceinline__ void bias1(float (&s)[16], const f32x16& S, float c0, float slope2) {
    if constexpr (R < 16) { const float t = a_addk<(R & 3) + 8 * (R >> 2)>(c0); const float v = a_fma_nabs(slope2, t, S[R]);
        if constexpr (EDGE) s[R] = (__builtin_fabsf(t) > (float)SIDE) ? -1e30f : v; else s[R] = v;
        bias1<SIDE, EDGE, R + 1>(s, S, c0, slope2); }
}
template <int SIDE>
__device__ __forceinline__ void softmax_step(f32x16& S, float c0, float slope2, bool edge, bool fresh, float& m, float& l, f32x16& o0, f32x16& o1, bool& mz, bf16x8& pk0, bf16x8& pk1) {
    asm volatile("s_nop 15\n\ts_nop 7" : "+v"(S));
    float s[16];
    if (edge) bias1<SIDE, true, 0>(s, S, c0, slope2); else bias1<SIDE, false, 0>(s, S, c0, slope2);
    if (!mz) {
#pragma unroll
        for (int r = 0; r < 16; ++r) s[r] = a_sub(s[r], m);
    }
    float ra = __builtin_fmaxf(__builtin_fmaxf(s[0], s[1]), s[2]), rb = __builtin_fmaxf(__builtin_fmaxf(s[3], s[4]), s[5]);
    ra = __builtin_fmaxf(__builtin_fmaxf(ra, s[6]), s[7]); rb = __builtin_fmaxf(__builtin_fmaxf(rb, s[8]), s[9]);
    ra = __builtin_fmaxf(__builtin_fmaxf(ra, s[10]), s[11]); rb = __builtin_fmaxf(__builtin_fmaxf(rb, s[12]), s[13]);
    ra = __builtin_fmaxf(__builtin_fmaxf(ra, s[14]), s[15]);
    const float rm = swap32max(__builtin_fmaxf(ra, rb));
    const bool need = fresh ? __any(rm > THR || rm < -64.0f) : __any(rm > THR);
    if (need) {
        const float dl = fresh ? rm : __builtin_fmaxf(rm, 0.f);
        m += dl; mz = false;
#pragma unroll
        for (int r = 0; r < 16; ++r) s[r] -= dl;
        if (!fresh) { const float f = __builtin_amdgcn_exp2f(-dl); l *= f; o0 = o0 * f; o1 = o1 * f; }
    }
#pragma unroll
    for (int r = 0; r < 16; ++r) s[r] = __builtin_amdgcn_exp2f(s[r]);
    asm volatile("s_nop 1" : "+v"(s[0]), "+v"(s[1]), "+v"(s[2]), "+v"(s[3]), "+v"(s[4]), "+v"(s[5]), "+v"(s[6]), "+v"(s[7]), "+v"(s[8]), "+v"(s[9]), "+v"(s[10]), "+v"(s[11]), "+v"(s[12]), "+v"(s[13]), "+v"(s[14]), "+v"(s[15]));
    float p0 = a_add(s[0], s[1]), p1 = a_add(s[2], s[3]);
#pragma unroll
    for (int r = 4; r < 16; r += 2) { p0 = a_add(p0, s[r]); p1 = a_add(p1, s[r + 1]); }
    l += a_add(p0, p1);
    u32x4 w0, w1;
    w0[0] = cvtpk(s[0], s[1]); w0[1] = cvtpk(s[2], s[3]); w0[2] = cvtpk(s[4], s[5]); w0[3] = cvtpk(s[6], s[7]);
    w1[0] = cvtpk(s[8], s[9]); w1[1] = cvtpk(s[10], s[11]); w1[2] = cvtpk(s[12], s[13]); w1[3] = cvtpk(s[14], s[15]);
    pk0 = __builtin_bit_cast(bf16x8, w0); pk1 = __builtin_bit_cast(bf16x8, w1);
}

struct QState { float m, l; f32x16 o0, o1; bool mz, fresh; };

template <int SIDE>
__device__ __forceinline__ void pair(const unsigned short* pb, int tqA, int dil, int qoff, int koff, int voff, float slope2, QState& A, QState& B, unsigned ldsw, const ATT_LAS unsigned char* ldsp, int lane, float& tsacc, bool tson) {
    constexpr int NT = (2 * SIDE + 32) / 32;
    TS_T0(2)
    const int u = lane & 31, hi = lane >> 5;
    int tlo = 0, thi = NT;
    while (tqA + dil * (32 * tlo - SIDE) < 0) ++tlo;
    while (tqA + dil * (32 * thi - SIDE) >= SEQL) --thi;
    const int r8 = lane >> 3;
    const unsigned short* kbase = pb + (size_t)(tqA + dil * (r8 - SIDE)) * LD + koff + 8 * ((lane & 7) ^ (r8 >> 1));
    const unsigned short* vbase = pb + (size_t)(tqA + dil * (r8 - SIDE)) * LD + voff + 8 * ((lane & 7) ^ (4 * ((r8 >> 1) & 1)));
    const int kx = 8 * ((((lane & 7) ^ (r8 >> 1)) ^ 4) - ((lane & 7) ^ (r8 >> 1)));
    const size_t rstep = (size_t)dil * LD;
#define ATT_DMA_K(t, slot) do { const unsigned short* p_ = kbase + (size_t)(32 * (t)) * rstep; const unsigned d_ = ldsw + (slot) * 8192u; \
        glds16(p_, d_); glds16(p_ + 8 * rstep + kx, d_ + 1024u); glds16(p_ + 16 * rstep, d_ + 2048u); glds16(p_ + 24 * rstep + kx, d_ + 3072u); } while (0)
#define ATT_DMA_V(t, slot) do { const unsigned short* p_ = vbase + (size_t)(32 * (t)) * rstep; const unsigned d_ = ldsw + (slot) * 8192u + 4096u; \
        glds16(p_, d_); glds16(p_ + 8 * rstep, d_ + 1024u); glds16(p_ + 16 * rstep, d_ + 2048u); glds16(p_ + 24 * rstep, d_ + 3072u); } while (0)
    ATT_DMA_K(tlo, tlo & 1); ATT_DMA_V(tlo, tlo & 1);
    if (tlo + 1 <= thi) { ATT_DMA_K(tlo + 1, (tlo + 1) & 1); ATT_DMA_V(tlo + 1, (tlo + 1) & 1); }
    bf16x8 qa[4], qb[4];
    { const unsigned short* qp = pb + (size_t)(tqA + u * dil) * LD + qoff + 8 * hi;
#pragma unroll
      for (int d0 = 0; d0 < 4; ++d0) { qa[d0] = *(const bf16x8*)(qp + 16 * d0); qb[d0] = *(const bf16x8*)(qp + (size_t)32 * rstep + 16 * d0); } }
    asm volatile("" : "+v"(qa[0]), "+v"(qa[1]), "+v"(qa[2]), "+v"(qa[3]), "+v"(qb[0]), "+v"(qb[1]), "+v"(qb[2]), "+v"(qb[3]));
    asm volatile("" : "+v"(A.o0), "+v"(A.o1), "+v"(B.o0), "+v"(B.o1), "+v"(A.m), "+v"(A.l), "+v"(B.m), "+v"(B.l));
    TS_T1(2)
    const int sw = (u >> 1) & 7;
    const int ka0 = u * 128 + (((0 + hi) ^ sw) << 4), ka1 = u * 128 + (((2 + hi) ^ sw) << 4), ka2 = u * 128 + (((4 + hi) ^ sw) << 4), ka3 = u * 128 + (((6 + hi) ^ sw) << 4);
    const int q_ = (lane & 15) >> 2, p_ = lane & 3, g16 = (lane >> 4) & 1;
    const int vb0 = 4096 + (4 * hi + q_) * 128 + ((4 * (q_ >> 1) + 2 * g16 + (p_ >> 1)) << 4) + 8 * (p_ & 1), vb1 = vb0 ^ 64;
    { TS_T0(3)
#pragma unroll 1
    for (int t = tlo; t <= thi; ++t) {
        const ATT_LAS unsigned char* sl = ldsp + (t & 1) * 8192;
        { TS_T0(5) if (t + 1 <= thi) ATT_WAITV(12); else ATT_WAITV(4);
        TS_T1(5) }
        bf16x8 kf[4];
        kf[0] = *(const ATT_LAS bf16x8*)(sl + ka0); kf[1] = *(const ATT_LAS bf16x8*)(sl + ka1); kf[2] = *(const ATT_LAS bf16x8*)(sl + ka2); kf[3] = *(const ATT_LAS bf16x8*)(sl + ka3);
        asm volatile("s_waitcnt lgkmcnt(0)" : "+v"(kf[0]), "+v"(kf[1]), "+v"(kf[2]), "+v"(kf[3]) :: "memory");
        if (t + 2 <= thi) ATT_DMA_K(t + 2, t & 1);
        const float c0 = (float)(32 * t - SIDE + 4 * hi - u);
        bf16x8 pa0, pa1, pb0, pb1;
        const bool actA = t <= NT - 1, actB = t >= 1;
        if (actA) {
            f32x16 S;
#pragma unroll
            for (int r = 0; r < 16; ++r) S[r] = 0.f;
#pragma unroll
            for (int d0 = 0; d0 < 4; ++d0) S = __builtin_amdgcn_mfma_f32_32x32x16_bf16(kf[d0], qa[d0], S, 0, 0, 0);
            softmax_step<SIDE>(S, c0, slope2, t == 0 || t == NT - 1, A.fresh, A.m, A.l, A.o0, A.o1, A.mz, pa0, pa1); A.fresh = false;
        }
        if (actB) {
            f32x16 S;
#pragma unroll
            for (int r = 0; r < 16; ++r) S[r] = 0.f;
#pragma unroll
            for (int d0 = 0; d0 < 4; ++d0) S = __builtin_amdgcn_mfma_f32_32x32x16_bf16(kf[d0], qb[d0], S, 0, 0, 0);
            softmax_step<SIDE>(S, c0 - 32.0f, slope2, t == 1 || t == NT, B.fresh, B.m, B.l, B.o0, B.o1, B.mz, pb0, pb1); B.fresh = false;
        }
        { TS_T0(5) if (t + 2 <= thi) ATT_WAITV(12); else if (t + 1 <= thi) ATT_WAITV(8); else ATT_WAITV(0);
        TS_T1(5) }
        {
            const s16x4 a0 = vtr(sl + vb0), a1 = vtr(sl + vb0 + 1024), b0 = vtr(sl + vb0 + 2048), b1 = vtr(sl + vb0 + 3072);
            bf16x8 v00 = __builtin_shufflevector(a0, a1, 0, 1, 2, 3, 4, 5, 6, 7), v01 = __builtin_shufflevector(b0, b1, 0, 1, 2, 3, 4, 5, 6, 7);
            if (actA) { A.o0 = __builtin_amdgcn_mfma_f32_32x32x16_bf16(v00, pa0, A.o0, 0, 0, 0); A.o0 = __builtin_amdgcn_mfma_f32_32x32x16_bf16(v01, pa1, A.o0, 0, 0, 0); }
            if (actB) { B.o0 = __builtin_amdgcn_mfma_f32_32x32x16_bf16(v00, pb0, B.o0, 0, 0, 0); B.o0 = __builtin_amdgcn_mfma_f32_32x32x16_bf16(v01, pb1, B.o0, 0, 0, 0); }
        }
        {
            const s16x4 c0_ = vtr(sl + vb1), c1 = vtr(sl + vb1 + 1024), d0_ = vtr(sl + vb1 + 2048), d1 = vtr(sl + vb1 + 3072);
            bf16x8 v10 = __builtin_shufflevector(c0_, c1, 0, 1, 2, 3, 4, 5, 6, 7), v11 = __builtin_shufflevector(d0_, d1, 0, 1, 2, 3, 4, 5, 6, 7);
            asm volatile("s_waitcnt lgkmcnt(0)" : "+v"(v10), "+v"(v11) :: "memory");
            if (t + 2 <= thi) ATT_DMA_V(t + 2, t & 1);
            if (actA) { A.o1 = __builtin_amdgcn_mfma_f32_32x32x16_bf16(v10, pa0, A.o1, 0, 0, 0); A.o1 = __builtin_amdgcn_mfma_f32_32x32x16_bf16(v11, pa1, A.o1, 0, 0, 0); }
            if (actB) { B.o1 = __builtin_amdgcn_mfma_f32_32x32x16_bf16(v10, pb0, B.o1, 0, 0, 0); B.o1 = __builtin_amdgcn_mfma_f32_32x32x16_bf16(v11, pb1, B.o1, 0, 0, 0); }
        }
    }
    TS_T1(3) }
#undef ATT_DMA_K
#undef ATT_DMA_V
}
__device__ __forceinline__ void finish(const QState& Q, unsigned short* yrow, float* ssyp, int hi) {
    const float lt = Q.l + __shfl_xor(Q.l, 32), inv = 1.0f / lt; float sq = 0.f;
#pragma unroll
    for (int g = 0; g < 4; ++g) {
        const float a0 = Q.o0[4 * g] * inv, a1 = Q.o0[4 * g + 1] * inv, a2 = Q.o0[4 * g + 2] * inv, a3 = Q.o0[4 * g + 3] * inv;
        const float b0 = Q.o1[4 * g] * inv, b1 = Q.o1[4 * g + 1] * inv, b2 = Q.o1[4 * g + 2] * inv, b3 = Q.o1[4 * g + 3] * inv;
        sq += ((a0 * a0 + a1 * a1) + (a2 * a2 + a3 * a3)) + ((b0 * b0 + b1 * b1) + (b2 * b2 + b3 * b3));
        u32x2 wa, wb; wa[0] = cvtpk(a0, a1); wa[1] = cvtpk(a2, a3); wb[0] = cvtpk(b0, b1); wb[1] = cvtpk(b2, b3);
        *(u32x2*)(yrow + 8 * g + 4 * hi) = wa; *(u32x2*)(yrow + 32 + 8 * g + 4 * hi) = wb;
    }
    sq += __shfl_xor(sq, 32);
    if (hi == 0) *ssyp = sq;
}
__device__ __forceinline__ void st_load(QState& Q, const float* stO, const float* stML, int ts, int hi) {
    const f32x2_t ml = *(const f32x2_t*)(stML + 2 * ts); Q.m = ml[0]; Q.l = hi == 0 ? ml[1] : 0.f; Q.mz = !__any(ml[0] != 0.f); Q.fresh = false;
#pragma unroll
    for (int g = 0; g < 4; ++g) { const f32x4 a = *(const f32x4*)(stO + ts * 64 + 8 * g + 4 * hi), c = *(const f32x4*)(stO + ts * 64 + 32 + 8 * g + 4 * hi);
        Q.o0[4 * g] = a[0]; Q.o0[4 * g + 1] = a[1]; Q.o0[4 * g + 2] = a[2]; Q.o0[4 * g + 3] = a[3]; Q.o1[4 * g] = c[0]; Q.o1[4 * g + 1] = c[1]; Q.o1[4 * g + 2] = c[2]; Q.o1[4 * g + 3] = c[3]; }
}
__device__ __forceinline__ void st_save(const QState& Q, float* stO, float* stML, int ts, int hi) {
    const float lt = Q.l + __shfl_xor(Q.l, 32);
    if (hi == 0) { f32x2_t ml; ml[0] = Q.m; ml[1] = lt; *(f32x2_t*)(stML + 2 * ts) = ml; }
#pragma unroll
    for (int g = 0; g < 4; ++g) { f32x4 a, c; a[0] = Q.o0[4 * g]; a[1] = Q.o0[4 * g + 1]; a[2] = Q.o0[4 * g + 2]; a[3] = Q.o0[4 * g + 3]; c[0] = Q.o1[4 * g]; c[1] = Q.o1[4 * g + 1]; c[2] = Q.o1[4 * g + 2]; c[3] = Q.o1[4 * g + 3];
        *(f32x4*)(stO + ts * 64 + 8 * g + 4 * hi) = a; *(f32x4*)(stO + ts * 64 + 32 + 8 * g + 4 * hi) = c; }
}
__device__ __forceinline__ void st_init(QState& Q, float l, bool fresh) { Q.m = 0.f; Q.l = l; Q.mz = true; Q.fresh = fresh;
#pragma unroll
    for (int r = 0; r < 16; ++r) { Q.o0[r] = 0.f; Q.o1[r] = 0.f; } }
__device__ __forceinline__ void phase(const unsigned short* proj, const float* sink, unsigned short* Y, float* SSY, unsigned char* state_ws, ATT_LAS unsigned char* lds, int vcu, int G, float* tsw) {
    constexpr int NB = 8, NITEM = 2 * NB * 8 * (SEQL / SPAN);
    int tid_ = threadIdx.x; asm volatile("" : "+v"(tid_));
    const int lane = tid_ & 63, wave = __builtin_amdgcn_readfirstlane(tid_ >> 6), u = lane & 31, hi = lane >> 5;
    const ATT_LAS unsigned char* ldsp = lds + wave * 16384;
    const unsigned ldsw = (unsigned)__builtin_amdgcn_readfirstlane((int)(unsigned)(uintptr_t)ldsp);
    float* stO = (float*)(state_ws + (size_t)blockIdx.x * ST_BYTES); float* stML = stO + SPAN * 64;
    float tsacc = 0.f; const bool tson0 = TS_PROBE != 0 && vcu == 1 && wave == 0;
    for (int it = vcu; it < NITEM; it += G)
    for (int rep_ = 0; rep_ < ((ATT_PROBE == 3 && it >= NITEM / 2) || (ATT_PROBE == 4 && it < NITEM / 2) ? 2 : 1); ++rep_) {
        const bool dg = it < NITEM / 2; const int id = dg ? it : it - NITEM / 2;
        const int span = id & 3, h = (id >> 2) & 7, b = id >> 5, tok0 = span * SPAN, h16 = dg ? h : 8 + h;
        const unsigned short* pb = proj + (size_t)b * SEQL * LD;
        const float slope = __builtin_amdgcn_exp2f(-0.5f * (float)((dg ? 8 + h : h) + 1)) * 1.4426950408889634f;
        if (dg) {
            const bool tson = tson0 && TS_PROBE < 10; TS_T0(1)
            const int qoff = h * 64, koff = 512 + h * 64, voff = 1024 + h * 64;
#pragma unroll 1
            for (int pass = 0; pass < 3; ++pass) {
                const int dil = pass == 0 ? 16 : (pass == 1 ? 4 : 1);
#pragma unroll 1
                for (int k = 0; k < 2; ++k) {
                    const int p = wave + 8 * k;
                    const int tqA = tok0 + (pass == 0 ? p : (pass == 1 ? 256 * (p >> 2) + (p & 3) : 64 * p));
                    const int tsA = tqA - tok0 + u * dil, tsB = tsA + 32 * dil;
                    QState A, B;
                    if (pass == 0) { st_init(A, 0.f, true); st_init(B, 0.f, true); }
                    else { TS_T0(6) st_load(A, stO, stML, tsA, hi); st_load(B, stO, stML, tsB, hi); asm volatile("" : "+v"(A.o0), "+v"(A.o1), "+v"(B.o0), "+v"(B.o1)); TS_T1(6) }
                    pair<64>(pb, tqA, dil, qoff, koff, voff, slope * (float)dil, A, B, ldsw, ldsp, lane, tsacc, tson && TS_PROBE < 10);
#if ATT_PROBE == 1
                    { QState A2 = A, B2 = B; pair<64>(pb, tqA, dil, qoff, koff, voff, slope * (float)dil, A2, B2, ldsw, ldsp, lane, tsacc, false);
                      float sm = A2.m + A2.l + B2.m + B2.l;
#pragma unroll
                      for (int r = 0; r < 16; ++r) sm += A2.o0[r] + A2.o1[r] + B2.o0[r] + B2.o1[r];
                      if (sm == 12345.678f) stML[0] = sm; }
#endif
#if ATT_PROBE == 2
                    if (pass < 2) { st_save(A, stO, stML, tsA, hi); st_save(B, stO, stML, tsB, hi); asm volatile("s_waitcnt vmcnt(0)" ::: "memory"); st_load(A, stO, stML, tsA, hi); st_load(B, stO, stML, tsB, hi); A.l = A.l + __shfl_xor(A.l, 32) * 0.f; }
#endif
                    if (pass < 2) { TS_T0(7) st_save(A, stO, stML, tsA, hi); st_save(B, stO, stML, tsB, hi); if (TS_PROBE == 7) asm volatile("s_waitcnt vmcnt(0)" ::: "memory"); TS_T1(7) }
                    else { TS_T0(4) const size_t tok = (size_t)b * SEQL + tqA + u; finish(A, Y + tok * 1024 + h16 * 64, SSY + tok * 16 + h16, hi); finish(B, Y + (tok + 32) * 1024 + h16 * 64, SSY + (tok + 32) * 16 + h16, hi); if (TS_PROBE == 4) asm volatile("s_waitcnt vmcnt(0)" ::: "memory"); TS_T1(4) }
                }
                { TS_T0(8) __syncthreads(); TS_T1(8) }
            }
            TS_T1(1)
        } else {
            const bool tson = tson0 && TS_PROBE >= 10; TS_T0(1)
            const int qoff = 1536 + h * 64, koff = 2048 + (h >> 2) * 64, voff = 2176 + (h >> 2) * 64;
            const float sk2 = sink[h] * 1.4426950408889634f;
#pragma unroll 1
            for (int k = 0; k < 2; ++k) {
                const int tqA = tok0 + 64 * (wave + 8 * k);
                const float lsink = hi == 0 ? __builtin_amdgcn_exp2f(sk2) : 0.f;
                QState A, B; st_init(A, lsink, false); st_init(B, lsink, false);
                pair<128>(pb, tqA, 1, qoff, koff, voff, slope, A, B, ldsw, ldsp, lane, tsacc, tson && TS_PROBE >= 10);
#if ATT_PROBE == 1
                { QState A2 = A, B2 = B; pair<128>(pb, tqA, 1, qoff, koff, voff, slope, A2, B2, ldsw, ldsp, lane, tsacc, false);
                  float sm = A2.m + A2.l + B2.m + B2.l;
#pragma unroll
                  for (int r = 0; r < 16; ++r) sm += A2.o0[r] + A2.o1[r] + B2.o0[r] + B2.o1[r];
                  if (sm == 12345.678f) stML[0] = sm; }
#endif
                { TS_T0(4) const size_t tok = (size_t)b * SEQL + tqA + u; finish(A, Y + tok * 1024 + h16 * 64, SSY + tok * 16 + h16, hi); finish(B, Y + (tok + 32) * 1024 + h16 * 64, SSY + (tok + 32) * 16 + h16, hi); if (TS_PROBE == 14) asm volatile("s_waitcnt vmcnt(0)" ::: "memory"); TS_T1(4) }
            }
            TS_T1(1)
        }
    }
    if (TS_PROBE != 0 && tson0 && lane == 0) atomicAdd(tsw, tsacc);
    __syncthreads();
}
#undef ATT_LAS
}

struct Frame {
    LAS unsigned char* lds;
    volatile LAS unsigned* MISC;
    gu32* ctl;
    int tid, lane, wave;
    int vcu, G;
};
__device__ __forceinline__ float wave_sum(float v) {
#pragma unroll
    for (int o = 1; o < 64; o <<= 1) v += __shfl_xor(v, o);
    return v;
}
__device__ __forceinline__ void p0_item(const float* W, int K, int N, bf16* WT, int out_row0, const float* gk, float nscale, LAS float* scr, int k0, int n0, int lane) {
#pragma unroll 8
    for (int i = 0; i < 32; ++i) { const int kk = 2 * i + (lane >> 5); const float g = gk ? gk[k0 + kk] : 1.0f; scr[kk * 33 + (lane & 31)] = W[(size_t)(k0 + kk) * N + n0 + (lane & 31)] * (g * nscale); }
    LDS_WAIT(); asm volatile("" ::: "memory");
    const int c = lane & 7;
#pragma unroll
    for (int j = 0; j < 4; ++j) { const int n = (lane >> 3) + 8 * j; const LAS float* s = scr + (8 * c) * 33 + n;
        v4u o; o.x = pk2(s[0 * 33], s[1 * 33]); o.y = pk2(s[2 * 33], s[3 * 33]); o.z = pk2(s[4 * 33], s[5 * 33]); o.w = pk2(s[6 * 33], s[7 * 33]);
        *(GAS v4u*)(WT + (size_t)(out_row0 + n) * K + k0 + 8 * c) = o; }
    LDS_WAIT(); asm volatile("" ::: "memory");
}
struct Ptrs {
    const float *x, *g_mix, *w_in, *g_out_dil, *g_out_win, *sink, *w_out, *g_ffn, *w_gate, *w_up, *w_down, *g_final;
    float* out; unsigned char* ws;
};
__device__ __forceinline__ void p0_prologue(Frame& F0, const Ptrs& P) {
    Frame F = F0; { int t_ = threadIdx.x; asm volatile("" : "+v"(t_)); F.tid = t_; F.lane = t_ & 63; F.wave = __builtin_amdgcn_readfirstlane(t_ >> 6); }
    LAS float* scr = (LAS float*)(F.lds + RING_OFF + F.wave * 16384);
    const int gw = F.vcu * NWAVES + F.wave, NGW = F.G * NWAVES;
    constexpr int I_IN = (D / 64) * (IN_COLS / 32), I_OUT = (D / 64) * (D / 32), I_G = (D / 64) * (FF / 32), I_D = (FF / 64) * (D / 32);
    constexpr int I_LAYER = I_IN + I_OUT + 2 * I_G + I_D;
    for (int it = gw; it < DEPTH * I_LAYER; it += NGW) {
        const int L = it / I_LAYER; int r = it % I_LAYER;
        bf16* wl = (bf16*)(P.ws + WS_W + (size_t)L * W_LAYER);
        if (r < I_IN) { const int nblk = IN_COLS / 32, kb = r / nblk, nb = r % nblk, n0 = 32 * nb; const bool isq = (n0 < 512) || (n0 >= 1536 && n0 < 2048);
            p0_item(P.w_in + (size_t)L * D * IN_COLS, D, IN_COLS, (bf16*)((unsigned char*)wl + W_IN), n0, P.g_mix + L * D, isq ? C2 : 1.0f, scr, 64 * kb, n0, F.lane); continue; } r -= I_IN;
        if (r < I_OUT) { const int nblk = D / 32, kb = r / nblk, nb = r % nblk, n0 = 32 * nb, k0 = 64 * kb;
            const float* gk = (k0 < 512) ? (P.g_out_dil + L * 512) : (P.g_out_win + L * 512 - 512);
            p0_item(P.w_out + (size_t)L * D * D, D, D, (bf16*)((unsigned char*)wl + W_OUT), n0, gk, 1.0f, scr, k0, n0, F.lane); continue; } r -= I_OUT;
        if (r < 2 * I_G) { const bool up = r >= I_G; if (up) r -= I_G; const int nblk = FF / 32, kb = r / nblk, nb = r % nblk, n0 = 32 * nb;
            const int orow = 256 * (n0 / 128) + (up ? 128 : 0) + (n0 % 128);
            p0_item((up ? P.w_up : P.w_gate) + (size_t)L * D * FF, D, FF, (bf16*)((unsigned char*)wl + W_GU), orow, P.g_ffn + L * D, 1.0f, scr, 64 * kb, n0, F.lane); continue; } r -= 2 * I_G;
        { const int nblk = D / 32, kb = r / nblk, nb = r % nblk, n0 = 32 * nb;
            p0_item(P.w_down + (size_t)L * FF * D, FF, D, (bf16*)((unsigned char*)wl + W_DOWN), n0, nullptr, 1.0f, scr, 64 * kb, n0, F.lane); }
    }
    bf16* XB = (bf16*)(P.ws + WS_XB); float* ss = (float*)(P.ws + WS_SS_MIX);
    for (int m = gw; m < M; m += NGW) {
        const GAS f32x4* xr = (const GAS f32x4*)(P.x + (size_t)m * D) + F.lane;
        f32x4 v[4]; float s = 0.f;
#pragma unroll
        for (int j = 0; j < 4; ++j) { v[j] = xr[64 * j]; s += (v[j].x * v[j].x + v[j].y * v[j].y) + (v[j].z * v[j].z + v[j].w * v[j].w); }
        s = wave_sum(s);
        GAS unsigned long long* o8 = (GAS unsigned long long*)(XB + (size_t)m * D) + F.lane;
#pragma unroll
        for (int j = 0; j < 4; ++j) o8[64 * j] = (unsigned long long)pk2(v[j].x, v[j].y) | ((unsigned long long)pk2(v[j].z, v[j].w) << 32);
        if (F.lane < 16) ss[(size_t)m * 16 + F.lane] = (F.lane == 0) ? s : 0.f;
    }
}
__device__ __forceinline__ void final_norm(Frame& F0, const Ptrs& P) {
    Frame F = F0; { int t_ = threadIdx.x; asm volatile("" : "+v"(t_)); F.tid = t_; F.lane = t_ & 63; F.wave = __builtin_amdgcn_readfirstlane(t_ >> 6); }
    const int gw = F.vcu * NWAVES + F.wave, NGW = F.G * NWAVES; const float* ss = (const float*)(P.ws + WS_SS_MIX); const bf16* XB = (const bf16*)(P.ws + WS_XB);
    f32x4 g[4];
#pragma unroll
    for (int j = 0; j < 4; ++j) g[j] = ((const GAS f32x4*)P.g_final)[F.lane + 64 * j];
    for (int m = gw; m < M; m += NGW) {
        const GAS unsigned long long* xr = (const GAS unsigned long long*)(XB + (size_t)m * D) + F.lane;
        GAS f32x4* orow = (GAS f32x4*)(P.out + (size_t)m * D) + F.lane;
        const float rs = __builtin_amdgcn_rsqf(pg8::ss_row_sum(ss, m) * (1.0f / 1024.0f) + EPS);
#pragma unroll
        for (int j = 0; j < 4; ++j) { const unsigned long long w = xr[64 * j]; const unsigned lo = (unsigned)w, hi = (unsigned)(w >> 32);
            f32x4 v; v.x = __uint_as_float(lo << 16); v.y = __uint_as_float(lo & 0xffff0000u); v.z = __uint_as_float(hi << 16); v.w = __uint_as_float(hi & 0xffff0000u);
            orow[64 * j] = v * rs * g[j]; }
    }
#if defined(TS_PROBE) && TS_PROBE != 0
    if (F.vcu == 1 && F.wave == 0 && F.lane == 0) P.out[(size_t)8 * D] = TS_SCALE * __hip_atomic_load((float*)(P.ws + WS_CTL) + 2048, __ATOMIC_RELAXED, __HIP_MEMORY_SCOPE_AGENT);
#endif
}
template <int MODE> __device__ __forceinline__ void rs_prepass(const pg8::StaticOrder& S, const float* ss, float* tab) {
    int tid = threadIdx.x; asm volatile("" : "+v"(tid));
    pg8::Unit u;
    for (int i = 0; S.next(i, u); ++i)
        for (int r = tid; r < 256; r += NWAVES * 64) { const int row = u.pm * 256 + r;
            const f32x4* p = (const f32x4*)(ss + (size_t)row * 16); const f32x4 a = p[0], b = p[1], c = p[2], d = p[3];
            const float s0 = ((a[0] + a[1]) + (a[2] + a[3])) + ((b[0] + b[1]) + (b[2] + b[3])), s1 = ((c[0] + c[1]) + (c[2] + c[3])) + ((d[0] + d[1]) + (d[2] + d[3]));
            if (MODE == 0) tab[row] = __builtin_amdgcn_rsqf((s0 + s1) * (1.0f / 1024.0f) + EPS);
            else { const float ra = __builtin_amdgcn_rsqf(s0 * (1.0f / 512.0f) + EPS), rb = __builtin_amdgcn_rsqf(s1 * (1.0f / 512.0f) + EPS); pg8::f32x2 v; v[0] = ra * __builtin_amdgcn_rcpf(rb); v[1] = rb; ((pg8::f32x2*)tab)[row] = v; } }
    __syncthreads();
}

struct Args { const float* in[12]; float* out; unsigned char* ws; int ph_lo, ph_hi, li, pad; };
__global__ void __launch_bounds__(NWAVES * 64, 2) mk_fwd(Args args) {
    extern __shared__ __attribute__((aligned(16))) unsigned char lds[];
    Frame F;
    F.lds = (LAS unsigned char*)lds;
    F.MISC = (volatile LAS unsigned*)(F.lds + MISC_OFF);
    F.tid = threadIdx.x; F.lane = F.tid & 63; F.wave = __builtin_amdgcn_readfirstlane(F.tid >> 6);
    F.G = gridDim.x; { const int bx = blockIdx.x; F.vcu = (F.G % 8 == 0) ? (bx % 8) * (F.G / 8) + bx / 8 : bx; }
    unsigned char* ws = args.ws;
    F.ctl = (gu32*)(ws + WS_CTL);
    Ptrs P; P.x = args.in[0]; P.g_mix = args.in[1]; P.w_in = args.in[2]; P.g_out_dil = args.in[3]; P.g_out_win = args.in[4]; P.sink = args.in[5]; P.w_out = args.in[6];
    P.g_ffn = args.in[7]; P.w_gate = args.in[8]; P.w_up = args.in[9]; P.w_down = args.in[10]; P.g_final = args.in[11]; P.out = args.out; P.ws = ws;
    for (int u = F.tid; u < (LDS_BYTES - LDSCTL_OFF) / 4; u += NWAVES * 64) ((LAS unsigned*)(F.lds + LDSCTL_OFF))[u] = 0u;
    __syncthreads();
    XcdBarrier bar; bar.bar = (unsigned*)(F.ctl + CW_BAR); bar.x = 0; bar.st = nullptr;
    if (MK_ONE_LAUNCH) bar = xcd_barrier_post((unsigned*)(F.ctl + CW_BAR), F.MISC + 8);
    const int lo = args.ph_lo, hi = args.ph_hi;
#define IN(k) (lo <= (k) && (k) < hi)
#if defined(TS_PROBE) && TS_PROBE >= 100
#define PH_T0(k) unsigned long long pt0_ = 0; if (TS_PROBE - 100 == (k) && F.vcu == 1 && threadIdx.x == 0) pt0_ = __builtin_amdgcn_s_memrealtime();
#define PH_T1(k) if (TS_PROBE - 100 == (k) && F.vcu == 1 && threadIdx.x == 0) atomicAdd((float*)(ws + WS_CTL) + 2048, (float)(__builtin_amdgcn_s_memrealtime() - pt0_));
#else
#define PH_T0(k)
#define PH_T1(k)
#endif
#define SEAM(k) do { if (MK_ONE_LAUNCH && IN(k) && IN((k) + 1)) xcd_barrier(bar); } while (0)
    bf16* XB = (bf16*)(ws + WS_XB); bf16* PROJ = (bf16*)(ws + WS_PROJ); bf16* Y = (bf16*)(ws + WS_Y); bf16* ACT = (bf16*)(ws + WS_ACT);
    float* SS_MIX = (float*)(ws + WS_SS_MIX); float* SSY = (float*)(ws + WS_SSY); float* SS_FFN = (float*)(ws + WS_SS_FFN); float* RS = (float*)(ws + WS_RS);

    { PH_T0(0) if (IN(0)) { p0_prologue(F, P); if (MK_DUP == 9) p0_prologue(F, P); } SEAM(0); PH_T1(0) }
    for (int L = 0; L < DEPTH; ++L) {
        const int pb = 1 + 5 * L;
        const unsigned char* wl = ws + WS_W + (size_t)L * W_LAYER;
        { PH_T0(pb)
        for (int rep_ = 0; rep_ < (MK_DUP == 0 ? 2 : 1); ++rep_)
        if (IN(pb)) {
            pg8::Gemm g{XB, (const bf16*)(wl + W_IN), M, IN_COLS, D}; pg8::StaticOrder S; S.init(M, IN_COLS, F.G, (int)blockIdx.x);
            rs_prepass<0>(S, SS_MIX, RS); pg8::EpiProj E{PROJ, IN_COLS, RS};
            pg8::gemm_phase<pg8::EpiProj, pg8::StaticOrder, true, true>(F.lds + RING_OFF, g, S, E);
        } SEAM(pb); PH_T1(pb) }
        { PH_T0(pb + 1)
        for (int rep_ = 0; rep_ < (MK_DUP == 1 ? 2 : 1); ++rep_)
        if (IN(pb + 1)) { att::phase(PROJ, P.sink + L * 8, Y, SSY, ws + WS_ATT, F.lds + RING_OFF, F.vcu, F.G, (float*)(ws + WS_CTL) + 2048); } SEAM(pb + 1); PH_T1(pb + 1) }
        { PH_T0(pb + 2)
        for (int rep_ = 0; rep_ < ((MK_DUP == 2 && L == 0) ? 2 : 1); ++rep_)
        if (IN(pb + 2)) {
            pg8::Gemm g{Y, (const bf16*)(wl + W_OUT), M, D, D}; pg8::StaticOrder S; S.init(M, D, F.G, (int)blockIdx.x);
            rs_prepass<1>(S, SSY, RS); pg8::EpiRes<true> E{XB, SS_FFN, (const pg8::f32x2*)RS};
            pg8::gemm_phase<pg8::EpiRes<true>, pg8::StaticOrder, true, true>(F.lds + RING_OFF, g, S, E);
        } SEAM(pb + 2); PH_T1(pb + 2) }
        { PH_T0(pb + 3)
        for (int rep_ = 0; rep_ < (MK_DUP == 3 ? 2 : 1); ++rep_)
        if (IN(pb + 3)) {
            pg8::Gemm g{XB, (const bf16*)(wl + W_GU), M, GU, D}; pg8::StaticOrder S; S.init(M, GU, F.G, (int)blockIdx.x);
            rs_prepass<0>(S, SS_FFN, RS); pg8::EpiSwiglu E{ACT, FF, RS};
            pg8::gemm_phase<pg8::EpiSwiglu, pg8::StaticOrder, true, true>(F.lds + RING_OFF, g, S, E);
        } SEAM(pb + 3); PH_T1(pb + 3) }
        { PH_T0(pb + 4)
        if (IN(pb + 4)) {
            pg8::Gemm g{ACT, (const bf16*)(wl + W_DOWN), M, D, FF}; pg8::StaticOrder S; S.init(M, D, F.G, (int)blockIdx.x);
            pg8::EpiRes<false> E{XB, SS_MIX, nullptr};
            pg8::gemm_phase<pg8::EpiRes<false>, pg8::StaticOrder, true, true>(F.lds + RING_OFF, g, S, E);
        } SEAM(pb + 4); PH_T1(pb + 4) }
    }
    if (IN(11)) { final_norm(F, P); }
#undef IN
#undef SEAM
}

extern "C" void kernel_launch(void* const* d_in, const int* in_sizes, int n_in, void* d_out, int out_size, void* d_ws, size_t ws_size, hipStream_t stream) {
    static int grid = 0;
    if (grid == 0) {
        if (n_in != 12 || in_sizes[0] != M * D || out_size != M * D || ws_size < WS_END) { fprintf(stderr, "kernel_launch: unexpected sizes (n_in %d, in0 %d, out %d, ws %zu); nothing launched\n", n_in, n_in > 0 ? in_sizes[0] : -1, out_size, ws_size); grid = -1; return; }
        int dev = 0, cus = 0, per_cu = 0;
        if (hipGetDevice(&dev) != hipSuccess || hipDeviceGetAttribute(&cus, hipDeviceAttributeMultiprocessorCount, dev) != hipSuccess) { fprintf(stderr, "kernel_launch: device query failed\n"); grid = -1; return; }
        if (hipFuncSetAttribute((const void*)mk_fwd, hipFuncAttributeMaxDynamicSharedMemorySize, LDS_BYTES) != hipSuccess) { fprintf(stderr, "kernel_launch: hipFuncSetAttribute failed\n"); grid = -1; return; }
        if (hipOccupancyMaxActiveBlocksPerMultiprocessor(&per_cu, (const void*)mk_fwd, NWAVES * 64, LDS_BYTES) != hipSuccess || per_cu < 1) { fprintf(stderr, "kernel_launch: occupancy query reports %d workgroups per CU\n", per_cu); (void)hipGetLastError(); grid = -1; return; }
        grid = cus;
    }
    if (grid < 0) return;
    if (hipMemsetAsync((char*)d_ws + WS_CTL, 0, CTL_ZERO_BYTES, stream) != hipSuccess) { fprintf(stderr, "kernel_launch: memset failed\n"); return; }
    Args a{};
    for (int i = 0; i < 12; ++i) a.in[i] = (const float*)d_in[i];
    a.out = (float*)d_out; a.ws = (unsigned char*)d_ws;
#if MK_ONE_LAUNCH
    a.ph_lo = 0; a.ph_hi = NPHASE; a.li = 0;
    hipLaunchKernelGGL(mk_fwd, dim3(grid), dim3(NWAVES * 64), LDS_BYTES, stream, a);
#else
    for (int p = 0; p < NPHASE; ++p) { a.ph_lo = p; a.ph_hi = p + 1; a.li = p; hipLaunchKernelGGL(mk_fwd, dim3(grid), dim3(NWAVES * 64), LDS_BYTES, stream, a); }
#endif
    const hipError_t le = hipPeekAtLastError();
    if (le != hipSuccess) fprintf(stderr, "kernel_launch: launch failed: %s\n", hipGetErrorName(le));
}
```

```cpp
#define MK_ONE_LAUNCH 1
#include <hip/hip_runtime.h>
#include <cstdio>
#include <cstdint>
namespace pg8 {
#define PG8_LAS __attribute__((address_space(3)))
typedef unsigned short bf16_t;
typedef short bf16x8 __attribute__((ext_vector_type(8)));
typedef float f32x4 __attribute__((ext_vector_type(4)));
typedef unsigned u32x4 __attribute__((ext_vector_type(4)));
constexpr int BM = 256, BK = 64, HALF = 128, HTB = HALF * BK * 2  , STAGE_BYTES = 8 * HTB, NXCD = 8, WGM = 8;

__host__ __device__ __forceinline__ int lds_byte(int r, int c) { const int st = (r >> 4) * 2 + (c >> 5), rr = r & 15, cc = c & 31, ob = rr * 64 + cc * 2; return st * 1024 + (ob ^ (((ob >> 9) & 1) << 5)); }
__host__ __device__ __forceinline__ void stage_rc(int b, int& R, int& C) { const int st = b / 1024, sb = b % 1024, swz = sb ^ (((sb >> 9) & 1) << 5); R = (st >> 1) * 16 + swz / 64; C = (st & 1) * 32 + (swz % 64) / 2; }
__host__ __device__ __forceinline__ int perm32(int rho) { const int n = rho >> 4, i = rho & 15; return 8 * (i >> 2) + 4 * n + (i & 3); }

struct Unit { int pm, pn, idx; };
struct Gemm { const bf16_t* A; const bf16_t* Bt; int M, N, K; };

struct StaticOrder {
    int nM, nN, nwg, G, c;
    __host__ __device__ void init(int M, int N, int G_, int c_) { nM = M / BM; nN = N / BM; nwg = nM * nN; G = G_; c = c_; }
    __host__ __device__ bool next(int i, Unit& u) const {
        const long L = (long)i * G + c; if (L >= nwg) return false;
        int wgid = (int)L; { const int q = nwg / NXCD, r = nwg % NXCD, xcd = wgid % NXCD, off = wgid / NXCD; wgid = (xcd < r ? xcd * (q + 1) : r * (q + 1) + (xcd - r) * q) + off; }
        const int nig = WGM * nN, gid = wgid / nig, fm = gid * WGM, gsz = (nM - fm) < WGM ? (nM - fm) : WGM;
        u.pm = fm + ((wgid % nig) % gsz); u.pn = (wgid % nig) / gsz; u.idx = i; return true;
    }
    __device__ __forceinline__ void a_ready(const Unit&) const {}
    __device__ __forceinline__ void done(const Unit&) const {}
};


__device__ __forceinline__ unsigned cvt_pk_bf16(float lo, float hi) { unsigned r; asm volatile("v_cvt_pk_bf16_f32 %0, %1, %2" : "=v"(r) : "v"(lo), "v"(hi)); return r; }
typedef float f32x2 __attribute__((ext_vector_type(2)));
typedef unsigned u32x2 __attribute__((ext_vector_type(2)));
constexpr int NSS = 16;
__device__ __forceinline__ float ss_row_sum(const float* ss, int row) {
    const f32x4* p = (const f32x4*)(ss + (size_t)row * NSS);
    const f32x4 a = p[0], b = p[1], c = p[2], d = p[3];
    return ((a[0] + a[1]) + (a[2] + a[3])) + ((b[0] + b[1]) + (b[2] + b[3])) + ((c[0] + c[1]) + (c[2] + c[3])) + ((d[0] + d[1]) + (d[2] + d[3]));
}
struct EpiProj {
    static constexpr bool PERM = true, AFTER_DRAIN = false, MID = false; static constexpr int MID_T = -1;
    bf16_t* O; int ldc; const PG8_LAS float* rs_tab;
    __device__ __forceinline__ void mid(f32x4 (&acc)[2][2][4][2], const Unit& u, int wr, int wc, int fr, int fq) const {}
    __device__ __forceinline__ void operator()(const f32x4 (&acc)[2][2][4][2], const Unit& u, int wr, int wc, int fr, int fq) const {
        const int row0 = u.pm * BM + wr * 64 + fr, col0 = u.pn * BM + wc * 32 + 8 * fq;
        float rsv[2][4];
#pragma unroll
        for (int ai = 0; ai < 2; ++ai)
#pragma unroll
            for (int m = 0; m < 4; ++m) rsv[ai][m] = rs_tab[u.idx * BM + wr * 64 + fr + ai * HALF + m * 16];
#pragma unroll
        for (int ai = 0; ai < 2; ++ai)
#pragma unroll
            for (int m = 0; m < 4; ++m) { const int row = row0 + ai * HALF + m * 16;
                const float rs = rsv[ai][m];
                bf16_t* rowp = O + (size_t)row * ldc + col0;
#pragma unroll
                for (int bj = 0; bj < 2; ++bj) { const f32x4 v0 = acc[ai][bj][m][0] * rs, v1 = acc[ai][bj][m][1] * rs;
                    u32x4 w; w.x = cvt_pk_bf16(v0[0], v0[1]); w.y = cvt_pk_bf16(v0[2], v0[3]); w.z = cvt_pk_bf16(v1[0], v1[1]); w.w = cvt_pk_bf16(v1[2], v1[3]);
                    *(u32x4*)(rowp + bj * HALF) = w; } }
    }
};
struct EpiSwiglu {
    static constexpr bool PERM = true, AFTER_DRAIN = false, MID = false; static constexpr int MID_T = -1;
    bf16_t* O; int ldc; const PG8_LAS float* rs_tab;
    __device__ __forceinline__ void mid(f32x4 (&acc)[2][2][4][2], const Unit& u, int wr, int wc, int fr, int fq) const {}
    __device__ __forceinline__ float act1(float g, float up, float rs) const { const float z = g * rs; return z * __builtin_amdgcn_rcpf(1.0f + __builtin_amdgcn_exp2f(z * -1.4426950408889634f)) * (up * rs); }
    __device__ __forceinline__ void operator()(const f32x4 (&acc)[2][2][4][2], const Unit& u, int wr, int wc, int fr, int fq) const {
        const int row0 = u.pm * BM + wr * 64 + fr, col0 = u.pn * HALF + wc * 32 + 8 * fq;
        float rsv[2][4];
#pragma unroll
        for (int ai = 0; ai < 2; ++ai)
#pragma unroll
            for (int m = 0; m < 4; ++m) rsv[ai][m] = rs_tab[u.idx * BM + wr * 64 + fr + ai * HALF + m * 16];
#pragma unroll
        for (int ai = 0; ai < 2; ++ai)
#pragma unroll
            for (int m = 0; m < 4; ++m) { const int row = row0 + ai * HALF + m * 16;
                const float rs = rsv[ai][m];
                const f32x4 g0 = acc[ai][0][m][0], g1 = acc[ai][0][m][1], u0 = acc[ai][1][m][0], u1 = acc[ai][1][m][1];
                u32x4 w; w.x = cvt_pk_bf16(act1(g0[0], u0[0], rs), act1(g0[1], u0[1], rs)); w.y = cvt_pk_bf16(act1(g0[2], u0[2], rs), act1(g0[3], u0[3], rs));
                w.z = cvt_pk_bf16(act1(g1[0], u1[0], rs), act1(g1[1], u1[1], rs)); w.w = cvt_pk_bf16(act1(g1[2], u1[2], rs), act1(g1[3], u1[3], rs));
                *(u32x4*)(O + (size_t)row * ldc + col0) = w; }
    }
};
template <bool YSCALE> struct EpiRes {
    static constexpr bool PERM = true, AFTER_DRAIN = false, MID = YSCALE; static constexpr int MID_T = 8;
    bf16_t* xb; float* ssout; const PG8_LAS f32x2* ys;
    __device__ __forceinline__ void mid(f32x4 (&acc)[2][2][4][2], const Unit& u, int wr, int wc, int fr, int fq) const {
        if constexpr (YSCALE) {
            const int row0 = u.pm * BM + wr * 64 + fr;
            float fv[2][4];
#pragma unroll
            for (int ai = 0; ai < 2; ++ai)
#pragma unroll
                for (int m = 0; m < 4; ++m) fv[ai][m] = ys[u.idx * BM + wr * 64 + fr + ai * HALF + m * 16][0];
#pragma unroll
            for (int ai = 0; ai < 2; ++ai)
#pragma unroll
                for (int m = 0; m < 4; ++m)
#pragma unroll
                    for (int bj = 0; bj < 2; ++bj)
#pragma unroll
                        for (int n = 0; n < 2; ++n) acc[ai][bj][m][n] *= fv[ai][m];
        }
    }
    __device__ __forceinline__ void operator()(const f32x4 (&acc)[2][2][4][2], const Unit& u, int wr, int wc, int fr, int fq) const {
        const int row0 = u.pm * BM + wr * 64 + fr, col0 = u.pn * BM + wc * 32 + 8 * fq;
        float fsv[2][4];
#pragma unroll
        for (int ai = 0; ai < 2; ++ai)
#pragma unroll
            for (int m = 0; m < 4; ++m) fsv[ai][m] = YSCALE ? ys[u.idx * BM + wr * 64 + fr + ai * HALF + m * 16][1] : 1.0f;
#pragma unroll
        for (int ai = 0; ai < 2; ++ai) {
            u32x4 res[4][2];
#pragma unroll
            for (int m = 0; m < 4; ++m)
#pragma unroll
                for (int bj = 0; bj < 2; ++bj) res[m][bj] = *(const u32x4*)(xb + (size_t)(row0 + ai * HALF + m * 16) * 1024 + col0 + bj * HALF);
#pragma unroll
            for (int m = 0; m < 4; ++m) { const int row = row0 + ai * HALF + m * 16; const float fs = fsv[ai][m];
                float q = 0.f;
#pragma unroll
                for (int bj = 0; bj < 2; ++bj) { const u32x4 bb = res[m][bj];
                    f32x4 b0, b1; b0[0] = __uint_as_float(bb[0] << 16); b0[1] = __uint_as_float(bb[0] & 0xffff0000u); b0[2] = __uint_as_float(bb[1] << 16); b0[3] = __uint_as_float(bb[1] & 0xffff0000u);
                    b1[0] = __uint_as_float(bb[2] << 16); b1[1] = __uint_as_float(bb[2] & 0xffff0000u); b1[2] = __uint_as_float(bb[3] << 16); b1[3] = __uint_as_float(bb[3] & 0xffff0000u);
                    const f32x4 o0 = b0 + acc[ai][bj][m][0] * fs, o1 = b1 + acc[ai][bj][m][1] * fs;
                    u32x4 w; w.x = cvt_pk_bf16(o0[0], o0[1]); w.y = cvt_pk_bf16(o0[2], o0[3]); w.z = cvt_pk_bf16(o1[0], o1[1]); w.w = cvt_pk_bf16(o1[2], o1[3]);
                    *(u32x4*)(xb + (size_t)row * 1024 + col0 + bj * HALF) = w;
                    q += ((o0[0] * o0[0] + o0[1] * o0[1]) + (o0[2] * o0[2] + o0[3] * o0[3])) + ((o1[0] * o1[0] + o1[1] * o1[1]) + (o1[2] * o1[2] + o1[3] * o1[3])); }
                q += __shfl_xor(q, 16); q += __shfl_xor(q, 32);
                if (fq == 0) ssout[(size_t)row * NSS + u.pn * 4 + wc] = q; }
            asm volatile("" ::: "memory");
        }
    }
};

template <class Epi, class Sched, bool ALIGN_EPI = false, bool SP2 = false>
__device__ __forceinline__ void gemm_phase(PG8_LAS unsigned char* lds, const Gemm g, const Sched& S, const Epi& E) {
    int tid_ = threadIdx.x; asm volatile("" : "+v"(tid_));
    const int tid = tid_, wid = __builtin_amdgcn_readfirstlane(tid >> 6), lane = tid & 63, wr = wid >> 2, wc = wid & 3, fr = lane & 15, fq = lane >> 4;
    const int K = g.K, nt = K / BK;
    unsigned voffA[2], voffB[2];
#pragma unroll
    for (int i = 0; i < 2; ++i) { int R, C; stage_rc(tid * 16 + i * 8192, R, C); const int Rb = Epi::PERM ? ((R & ~31) + perm32(R & 31)) : R;
        voffA[i] = (unsigned)(R * K + C) * 2u; voffB[i] = (unsigned)(Rb * K + C) * 2u; }
    const size_t kstep = (size_t)(BK * 2);
    const size_t hstep = (size_t)HALF * K * 2;
    const size_t tstep = 2 * hstep;
    const unsigned ldsw = (unsigned)wid * 1024u;
    const int aoff = lds_byte(wr * 64 + fr, fq * 8), boff = lds_byte(wc * 32 + fr, fq * 8);
#define PG8_SA(b, h) (((b) * 2 + (h)) * HTB)
#define PG8_SB(b, h) ((4 + (b) * 2 + (h)) * HTB)
#define PG8_STAGE(bufoff, gbase, voff) do { _Pragma("unroll") for (int _i = 0; _i < 2; ++_i) \
        __builtin_amdgcn_global_load_lds((const unsigned*)((const char*)(gbase) + (voff)[_i]), (PG8_LAS unsigned*)(lds + (bufoff) + ldsw + _i * 8192), 16, 0, 0); } while (0)
#define PG8_LDA(dst, b, h) do { _Pragma("unroll") for (int m = 0; m < 4; ++m) _Pragma("unroll") for (int k = 0; k < 2; ++k) dst[m][k] = *(const PG8_LAS bf16x8*)(lds + PG8_SA(b, h) + aoff + m * 2048 + k * 1024); } while (0)
#define PG8_LDB(dst, b, h) do { _Pragma("unroll") for (int n = 0; n < 2; ++n) _Pragma("unroll") for (int k = 0; k < 2; ++k) dst[n][k] = *(const PG8_LAS bf16x8*)(lds + PG8_SB(b, h) + boff + n * 2048 + k * 1024); } while (0)
#define PG8_MMA(ai, bj, At, Bt) do { __builtin_amdgcn_s_setprio(1); _Pragma("unroll") for (int m = 0; m < 4; ++m) _Pragma("unroll") for (int n = 0; n < 2; ++n) _Pragma("unroll") for (int k = 0; k < 2; ++k) \
        acc[ai][bj][m][n] = __builtin_amdgcn_mfma_f32_16x16x32_bf16(Bt[n][k], At[m][k], acc[ai][bj][m][n], 0, 0, 0); __builtin_amdgcn_s_setprio(0); } while (0)
#define PG8_WAIT_V(n) asm volatile("s_waitcnt vmcnt(" #n ")" ::: "memory")
#define PG8_WAIT_L(n) asm volatile("s_waitcnt lgkmcnt(" #n ")" ::: "memory")
#define PG8_BAR __builtin_amdgcn_s_barrier()
#define PG8_SCHED __builtin_amdgcn_sched_barrier(0)
    Unit cur, nxt; int ui = 0;
    if (!S.next(0, cur)) return;
    f32x4 acc[2][2][4][2];
#pragma unroll
    for (int a = 0; a < 2; ++a)
#pragma unroll
        for (int b = 0; b < 2; ++b)
#pragma unroll
            for (int m = 0; m < 4; ++m)
#pragma unroll
                for (int n = 0; n < 2; ++n) acc[a][b][m][n] = (f32x4){0.f, 0.f, 0.f, 0.f};
    bf16x8 At[4][2], B0[2][2], B1[2][2];
    const char* cA = (const char*)g.A + (size_t)cur.pm * tstep; const char* cB = (const char*)g.Bt + (size_t)cur.pn * tstep;
    S.a_ready(cur);
    if constexpr (SP2) {
        PG8_STAGE(PG8_SB(0, 0), cB, voffB); PG8_STAGE(PG8_SB(0, 1), cB + hstep, voffB); PG8_STAGE(PG8_SA(0, 0), cA, voffA); PG8_STAGE(PG8_SA(0, 1), cA + hstep, voffA);
        if (wr == 1) PG8_BAR;
        PG8_WAIT_V(2); PG8_BAR;
        PG8_STAGE(PG8_SB(1, 0), cB + kstep, voffB); PG8_STAGE(PG8_SA(1, 0), cA + kstep, voffA); PG8_STAGE(PG8_SB(1, 1), cB + hstep + kstep, voffB);
        PG8_WAIT_V(6); PG8_BAR;
    } else {
        PG8_STAGE(PG8_SB(0, 0), cB, voffB); PG8_STAGE(PG8_SA(0, 0), cA, voffA); PG8_STAGE(PG8_SB(0, 1), cB + hstep, voffB); PG8_STAGE(PG8_SA(0, 1), cA + hstep, voffA);
        if (wr == 1) PG8_BAR;
        PG8_WAIT_V(4); PG8_BAR;
        PG8_STAGE(PG8_SB(1, 0), cB + kstep, voffB); PG8_STAGE(PG8_SA(1, 0), cA + kstep, voffA); PG8_STAGE(PG8_SB(1, 1), cB + hstep + kstep, voffB);
        PG8_WAIT_V(6); PG8_BAR;
    }
    for (;;) {
        const bool has_next = S.next(ui + 1, nxt);
        const char* nA = has_next ? (const char*)g.A + (size_t)nxt.pm * tstep : cA; const char* nB = has_next ? (const char*)g.Bt + (size_t)nxt.pn * tstep : cB;
        for (int t = 0; t < nt; t += 2) {
            const bool last = (t == nt - 2);
            const char* a1 = cA + (size_t)(t + 1) * kstep;
            const char* a2 = last ? nA : cA + (size_t)(t + 2) * kstep; const char* b2 = last ? nB : cB + (size_t)(t + 2) * kstep;
            const char* a3 = a2 + kstep; const char* b3 = b2 + kstep;
            if (last && has_next) S.a_ready(nxt);
            if constexpr (Epi::MID) { if (t == Epi::MID_T) E.mid(acc, cur, wr, wc, fr, fq); }
            if constexpr (SP2) {
            PG8_LDB(B0, 0, 0); PG8_LDB(B1, 0, 1); PG8_SCHED; PG8_LDA(At, 0, 0); PG8_STAGE(PG8_SA(1, 1), a1 + hstep, voffA);
            PG8_WAIT_V(8); PG8_WAIT_L(0); PG8_BAR; PG8_MMA(0, 0, At, B0); PG8_MMA(0, 1, At, B1); PG8_BAR; PG8_SCHED;
            PG8_LDA(At, 0, 1); PG8_STAGE(PG8_SB(0, 0), b2, voffB); PG8_STAGE(PG8_SB(0, 1), b2 + hstep, voffB); PG8_STAGE(PG8_SA(0, 0), a2, voffA);
            PG8_WAIT_V(8); PG8_WAIT_L(0); PG8_BAR; PG8_MMA(1, 0, At, B0); PG8_MMA(1, 1, At, B1); PG8_BAR; PG8_SCHED;
            PG8_LDB(B0, 1, 0); PG8_LDB(B1, 1, 1); PG8_SCHED; PG8_LDA(At, 1, 0); PG8_STAGE(PG8_SA(0, 1), a2 + hstep, voffA);
            PG8_WAIT_V(8); PG8_WAIT_L(0); PG8_BAR; PG8_MMA(0, 0, At, B0); PG8_MMA(0, 1, At, B1); PG8_BAR; PG8_SCHED;
            PG8_LDA(At, 1, 1); PG8_STAGE(PG8_SB(1, 0), b3, voffB); PG8_STAGE(PG8_SB(1, 1), b3 + hstep, voffB); PG8_STAGE(PG8_SA(1, 0), a3, voffA);
            PG8_WAIT_V(8); PG8_WAIT_L(0); PG8_BAR; PG8_MMA(1, 0, At, B0); PG8_MMA(1, 1, At, B1); PG8_BAR; PG8_SCHED;
            } else {
            PG8_LDB(B0, 0, 0); PG8_SCHED; PG8_LDA(At, 0, 0); PG8_STAGE(PG8_SA(1, 1), a1 + hstep, voffA);
            PG8_WAIT_L(8); PG8_BAR; PG8_WAIT_L(0); PG8_MMA(0, 0, At, B0); PG8_BAR; PG8_SCHED;
            PG8_LDB(B1, 0, 1); PG8_STAGE(PG8_SB(0, 0), b2, voffB);
            PG8_BAR; PG8_WAIT_L(0); PG8_MMA(0, 1, At, B1); PG8_BAR;
            PG8_LDA(At, 0, 1); PG8_STAGE(PG8_SA(0, 0), a2, voffA);
            PG8_BAR; PG8_WAIT_L(0); PG8_MMA(1, 0, At, B0); PG8_BAR; PG8_SCHED;
            PG8_STAGE(PG8_SB(0, 1), b2 + hstep, voffB);
            PG8_WAIT_V(6); PG8_BAR; PG8_MMA(1, 1, At, B1); PG8_BAR;
            PG8_LDB(B0, 1, 0); PG8_SCHED; PG8_LDA(At, 1, 0); PG8_STAGE(PG8_SA(0, 1), a2 + hstep, voffA);
            PG8_WAIT_L(8); PG8_BAR; PG8_WAIT_L(0); PG8_MMA(0, 0, At, B0); PG8_BAR; PG8_SCHED;
            PG8_LDB(B1, 1, 1); PG8_STAGE(PG8_SB(1, 0), b3, voffB);
            PG8_BAR; PG8_WAIT_L(0); PG8_MMA(0, 1, At, B1); PG8_BAR;
            PG8_LDA(At, 1, 1); PG8_STAGE(PG8_SA(1, 0), a3, voffA);
            PG8_BAR; PG8_WAIT_L(0); PG8_MMA(1, 0, At, B0); PG8_BAR; PG8_SCHED;
            PG8_STAGE(PG8_SB(1, 1), b3 + hstep, voffB);
            PG8_WAIT_V(6); PG8_BAR; PG8_MMA(1, 1, At, B1); PG8_BAR;
            }
        }
        if constexpr (ALIGN_EPI) { if (wr == 0) PG8_BAR; }
        if constexpr (!Epi::AFTER_DRAIN) { E(acc, cur, wr, wc, fr, fq); S.done(cur); }
        if (!has_next) break;
#pragma unroll
        for (int a = 0; a < 2; ++a)
#pragma unroll
            for (int b = 0; b < 2; ++b)
#pragma unroll
                for (int m = 0; m < 4; ++m)
#pragma unroll
                    for (int n = 0; n < 2; ++n) acc[a][b][m][n] = (f32x4){0.f, 0.f, 0.f, 0.f};
        cur = nxt; cA = nA; cB = nB; ++ui;
        if constexpr (ALIGN_EPI) { if (wr == 1) PG8_BAR; }
    }
    PG8_WAIT_V(0);
    if constexpr (!ALIGN_EPI) { if (wr == 0) PG8_BAR; }
    PG8_BAR;
    if constexpr (Epi::AFTER_DRAIN) { E.fused(acc, cur, wr, wc, fr, fq, lds, wid, lane); S.done(cur); }
#undef PG8_SA
#undef PG8_SB
#undef PG8_STAGE
#undef PG8_LDA
#undef PG8_LDB
#undef PG8_MMA
#undef PG8_WAIT_V
#undef PG8_WAIT_L
#undef PG8_BAR
#undef PG8_SCHED
}
}

constexpr int NWAVES = 8;
constexpr int BATCH = 8, SEQ = 4096, D = 1024, DEPTH = 2, M = BATCH * SEQ, IN_COLS = 2304, FF = 2816, GU = 2 * FF;
constexpr float EPS = 1e-6f, LOG2E = 1.4426950408889634f, C2 = 0.125f * LOG2E;
constexpr int NPHASE = 12;
#ifndef TS_SCALE
#define TS_SCALE 0.01f
#endif
#ifndef MK_DUP
#define MK_DUP -1
#endif
#ifndef MK_ONE_LAUNCH
#define MK_ONE_LAUNCH 0
#endif
constexpr size_t MiB = 1u << 20;
constexpr size_t WS_CTL = 0, CTL_ZERO_BYTES = 1 * MiB;
constexpr size_t WS_SS_MIX = 2 * MiB, WS_SSY = 4 * MiB, WS_SS_FFN = 6 * MiB;
constexpr size_t WS_RS = 1 * MiB;
constexpr size_t WS_W = 8 * MiB, W_LAYER = 23 * MiB, W_IN = 0, W_OUT = 9 * MiB / 2, W_GU = 13 * MiB / 2, W_DOWN = 35 * MiB / 2;
constexpr size_t WS_ATT = 368 * MiB;
constexpr size_t WS_XB = 96 * MiB, WS_PROJ = 160 * MiB, WS_Y = 304 * MiB, WS_ACT = 160 * MiB, WS_END = 440 * MiB;
constexpr int CW_BAR = 4096;
constexpr int RING_OFF = 0, RING_BYTES = 131072;
constexpr int LDSCTL_OFF = RING_BYTES, MISC_OFF = LDSCTL_OFF + 320;
constexpr int LDS_BYTES = 147456;
constexpr int TAB_OFF = LDSCTL_OFF + 512, TAB_UNITS = (LDS_BYTES - TAB_OFF) / 1024;
static_assert(TAB_UNITS >= 11 && TAB_OFF % 16 == 0, "row-scale tables: 11 units per workgroup in the gate/up phase on a 256-workgroup grid");
#define GAS __attribute__((address_space(1)))
#define LAS __attribute__((address_space(3)))
typedef unsigned short bf16;
typedef unsigned v4u __attribute__((ext_vector_type(4)));
typedef float f32x4 __attribute__((ext_vector_type(4)));
typedef short bf16x8 __attribute__((ext_vector_type(8)));
typedef GAS unsigned gu32;
typedef GAS unsigned long long gu64;
#define RLX_AGENT __ATOMIC_RELAXED, __HIP_MEMORY_SCOPE_AGENT
#define LDS_WAIT() asm volatile("s_waitcnt lgkmcnt(0)" ::: "memory")
#define VM_WAIT() asm volatile("s_waitcnt vmcnt(0)" ::: "memory")
__device__ __forceinline__ unsigned long long rt() { return __builtin_amdgcn_s_memrealtime(); }
__device__ __forceinline__ unsigned f2bf(float f) { unsigned u = __builtin_bit_cast(unsigned, f); return (u + 0x7fffu + ((u >> 16) & 1u)) >> 16; }
__device__ __forceinline__ unsigned pk2(float lo, float hi) { return f2bf(lo) | (f2bf(hi) << 16); }

#define XB_TMO      128
#define XB_XCNT(j)  (256  + 64 * (j))
#define XB_XSUB(j)  (1280 + 64 * (j))
#define XB_XGEN(j)  (2304 + 64 * (j))
#define XB_TOP      3328
#define XB_TOPGEN   3392
#define XCD_BAR_WORDS 3456
#define XB_SPIN_CAP (1u << 18)

__device__ __forceinline__ unsigned xb_ld(unsigned* p)              { return __hip_atomic_load(p, __ATOMIC_RELAXED, __HIP_MEMORY_SCOPE_AGENT); }
__device__ __forceinline__ unsigned xb_add(unsigned* p, unsigned v) { return __hip_atomic_fetch_add(p, v, __ATOMIC_RELAXED, __HIP_MEMORY_SCOPE_AGENT); }
__device__ __forceinline__ unsigned xb_xcc_id() { return (unsigned)__builtin_amdgcn_s_getreg((3 << 11) | 20) & 0xFu; }
#define XB_SPIN(cond, bar) do { unsigned _sp = 0; while (cond) { __builtin_amdgcn_s_sleep(1); \
    if ((++_sp & 255u) == 0u) { if (xb_ld(&(bar)[XB_TMO])) break; if (_sp > XB_SPIN_CAP) { atomicAdd(&(bar)[XB_TMO], 1u); break; } } } } while (0)

struct XcdBarrier {
    unsigned* bar; unsigned x;
    volatile LAS unsigned* st;
};

__device__ __forceinline__ XcdBarrier xcd_barrier_post(unsigned* bar, volatile LAS unsigned* st) {
    XcdBarrier b; b.bar = bar; b.x = xb_xcc_id(); b.st = st;
    if (threadIdx.x == 0) (void)xb_add(&bar[XB_XCNT(b.x)], 1u);
    return b;
}
__device__ __forceinline__ void xcd_barrier_complete(unsigned* bar, unsigned x, unsigned& nloc, unsigned& nx) {
    const unsigned G = gridDim.x * gridDim.y * gridDim.z;
    unsigned sum, cnt, mine, sp = 0u;
    for (;;) {
        sum = 0u; cnt = 0u; mine = 0u;
#pragma unroll
        for (unsigned j = 0; j < 16; ++j) { const unsigned c = xb_ld(&bar[XB_XCNT(j)]); sum += c; cnt += (c > 0u) ? 1u : 0u; mine = (j == x) ? c : mine; }
        if (sum == G) break;
        __builtin_amdgcn_s_sleep(1);
        if ((++sp & 255u) == 0u) { if (xb_ld(&bar[XB_TMO])) break; if (sp > XB_SPIN_CAP) { atomicAdd(&bar[XB_TMO], 1u); break; } }
    }
    nloc = mine > 0u ? mine : 1u; nx = cnt > 0u ? cnt : 1u;
}

__device__ __forceinline__ void xcd_barrier(const XcdBarrier& b) {
    asm volatile("s_waitcnt vmcnt(0)" ::: "memory");
    __syncthreads();
    if (threadIdx.x == 0) {
        unsigned* bar = b.bar;
        __builtin_amdgcn_s_waitcnt(0);
        unsigned nloc = b.st[0], nx = b.st[1];
        if (nloc == 0u) { xcd_barrier_complete(bar, b.x, nloc, nx); b.st[0] = nloc; b.st[1] = nx; }
        const unsigned old = xb_add(&bar[XB_XSUB(b.x)], 1u);
        const unsigned gen = old / nloc;
        if (old + 1u == (gen + 1u) * nloc) {
            __builtin_amdgcn_fence(__ATOMIC_RELEASE, "agent");
            asm volatile("s_waitcnt vmcnt(0)" ::: "memory");
            const unsigned og = xb_add(&bar[XB_TOP], 1u);
            const unsigned tg = og / nx;
            if (og + 1u == (tg + 1u) * nx) xb_add(&bar[XB_TOPGEN], 1u);
            else XB_SPIN(xb_ld(&bar[XB_TOPGEN]) == tg, bar);
            __builtin_amdgcn_fence(__ATOMIC_ACQUIRE, "agent");
            xb_add(&bar[XB_XGEN(b.x)], 1u);
            asm volatile("s_waitcnt vmcnt(0)" ::: "memory");
        } else {
            XB_SPIN(xb_ld(&bar[XB_XGEN(b.x)]) == gen, bar);
            __builtin_amdgcn_fence(__ATOMIC_ACQUIRE, "agent");
            asm volatile("s_waitcnt vmcnt(0)" ::: "memory");
        }
    }
    __syncthreads();
}

namespace att {
#ifndef TS_PROBE
#define TS_PROBE 0
#endif
#define TS_T0(k) unsigned long long ts0_ = 0; if ((TS_PROBE % 10) == (k) && tson) ts0_ = __builtin_amdgcn_s_memrealtime();
#define TS_T1(k) if ((TS_PROBE % 10) == (k) && tson) tsacc += (float)(__builtin_amdgcn_s_memrealtime() - ts0_);
#ifndef ATT_PROBE
#define ATT_PROBE 0
#endif
typedef short bf16x8 __attribute__((ext_vector_type(8)));
typedef short s16x4 __attribute__((ext_vector_type(4)));
typedef float f32x16 __attribute__((ext_vector_type(16)));
typedef float f32x4 __attribute__((ext_vector_type(4)));
typedef unsigned u32x4 __attribute__((ext_vector_type(4)));
typedef unsigned u32x2 __attribute__((ext_vector_type(2)));
typedef float f32x2_t __attribute__((ext_vector_type(2))); typedef __bf16 bf16x2_t __attribute__((ext_vector_type(2)));
typedef short v4i16_t __attribute__((ext_vector_type(4)));
#define ATT_LAS __attribute__((address_space(3)))
constexpr int SPAN = 1024, ST_BYTES = SPAN * 64 * 4 + SPAN * 8;
constexpr int LD = 2304, SEQL = 4096;
__device__ __forceinline__ unsigned cvtpk(float lo, float hi) { f32x2_t v = {lo, hi}; bf16x2_t b = __builtin_convertvector(v, bf16x2_t); return __builtin_bit_cast(unsigned, b); }
__device__ __forceinline__ s16x4 vtr(const ATT_LAS unsigned char* p) { return __builtin_bit_cast(s16x4, __builtin_amdgcn_ds_read_tr16_b64_v4i16((ATT_LAS v4i16_t*)p)); }
__device__ __forceinline__ void glds16(const void* gsrc, unsigned lds_dst) { unsigned keep;
#if ATT_PROBE == 5
    asm volatile("s_mov_b32 %0, m0\n\ts_mov_b32 m0, %2\n\ts_nop 0\n\tglobal_load_lds_dwordx4 %1, off\n\ts_mov_b32 m0, %0" : "=&s"(keep) : "v"(gsrc), "s"(lds_dst) : "memory");
#endif
    asm volatile("s_mov_b32 %0, m0\n\ts_mov_b32 m0, %2\n\ts_nop 0\n\tglobal_load_lds_dwordx4 %1, off\n\ts_mov_b32 m0, %0" : "=&s"(keep) : "v"(gsrc), "s"(lds_dst) : "memory"); }
#if ATT_PROBE == 5
#define ATT_WAITV(N) asm volatile("s_waitcnt vmcnt(%0)" :: "i"(2 * (N)) : "memory")
#else
#define ATT_WAITV(N) asm volatile("s_waitcnt vmcnt(" #N ")" ::: "memory")
#endif
#define ATT_WAITL() asm volatile("s_waitcnt lgkmcnt(0)" ::: "memory")

template <int K> __device__ __forceinline__ float a_addk(float a) { float r; asm("v_add_f32_e32 %0, %1, %2" : "=v"(r) : "i"(__builtin_bit_cast(int, (float)K)), "v"(a)); return r; }
__device__ __forceinline__ float a_add(float a, float b) { float r; asm("v_add_f32_e32 %0, %1, %2" : "=v"(r) : "v"(a), "v"(b)); return r; }
__device__ __forceinline__ float a_sub(float a, float b) { float r; asm("v_sub_f32_e32 %0, %1, %2" : "=v"(r) : "v"(a), "v"(b)); return r; }
__device__ __forceinline__ float a_fma_nabs(float sl, float x, float c) { float r; asm("v_fma_f32 %0, -%1, |%2|, %3" : "=v"(r) : "v"(sl), "v"(x), "v"(c)); return r; }
__device__ __forceinline__ float swap32max(float v) { auto rr = __builtin_amdgcn_permlane32_swap(__float_as_uint(v), __float_as_uint(v), false, false); return __builtin_fmaxf(__uint_as_float(rr[0]), __uint_as_float(rr[1])); }
constexpr float THR = 8.0f;

template <int SIDE, bool EDGE, int R> __device__ __forceinline__ void bias1(float (&s)[16], const f32x16& S, float c0, float slope2) {
    if constexpr (R < 16) { const float t = a_addk<(R & 3) + 8 * (R >> 2)>(c0); const float v = a_fma_nabs(slope2, t, S[R]);
        if constexpr (EDGE) s[R] = (__builtin_fabsf(t) > (float)SIDE) ? -1e30f : v; else s[R] = v;
        bias1<SIDE, EDGE, R + 1>(s, S, c0, slope2); }
}
template <int SIDE>
__device__ __forceinline__ void softmax_step(f32x16& S, float c0, float slope2, bool edge, bool fresh, float& m, float& l, f32x16& o0, f32x16& o1, bool& mz, bf16x8& pk0, bf16x8& pk1) {
    asm volatile("s_nop 15\n\ts_nop 7" : "+v"(S));
    float s[16];
    if (edge) bias1<SIDE, true, 0>(s, S, c0, slope2); else bias1<SIDE, false, 0>(s, S, c0, slope2);
    if (!mz) {
#pragma unroll
        for (int r = 0; r < 16; ++r) s[r] = a_sub(s[r], m);
    }
    float ra = __builtin_fmaxf(__builtin_fmaxf(s[0], s[1]), s[2]), rb = __builtin_fmaxf(__builtin_fmaxf(s[3], s[4]), s[5]);
    ra = __builtin_fmaxf(__builtin_fmaxf(ra, s[6]), s[7]); rb = __builtin_fmaxf(__builtin_fmaxf(rb, s[8]), s[9]);
    ra = __builtin_fmaxf(__builtin_fmaxf(ra, s[10]), s[11]); rb = __builtin_fmaxf(__builtin_fmaxf(rb, s[12]), s[13]);
    ra = __builtin_fmaxf(__builtin_fmaxf(ra, s[14]), s[15]);
    const float rm = swap32max(__builtin_fmaxf(ra, rb));
    const bool need = fresh ? __any(rm > THR || rm < -64.0f) : __any(rm > THR);
    if (need) {
        const float dl = fresh ? rm : __builtin_fmaxf(rm, 0.f);
        m += dl; mz = false;
#pragma unroll
        for (int r = 0; r < 16; ++r) s[r] -= dl;
        if (!fresh) { const float f = __builtin_amdgcn_exp2f(-dl); l *= f; o0 = o0 * f; o1 = o1 * f; }
    }
#pragma unroll
    for (int r = 0; r < 16; ++r) s[r] = __builtin_amdgcn_exp2f(s[r]);
    asm volatile("s_nop 1" : "+v"(s[0]), "+v"(s[1]), "+v"(s[2]), "+v"(s[3]), "+v"(s[4]), "+v"(s[5]), "+v"(s[6]), "+v"(s[7]), "+v"(s[8]), "+v"(s[9]), "+v"(s[10]), "+v"(s[11]), "+v"(s[12]), "+v"(s[13]), "+v"(s[14]), "+v"(s[15]));
    float p0 = a_add(s[0], s[1]), p1 = a_add(s[2], s[3]);
#pragma unroll
    for (int r = 4; r < 16; r += 2) { p0 = a_add(p0, s[r]); p1 = a_add(p1, s[r + 1]); }
    l += a_add(p0, p1);
    u32x4 w0, w1;
    w0[0] = cvtpk(s[0], s[1]); w0[1] = cvtpk(s[2], s[3]); w0[2] = cvtpk(s[4], s[5]); w0[3] = cvtpk(s[6], s[7]);
    w1[0] = cvtpk(s[8], s[9]); w1[1] = cvtpk(s[10], s[11]); w1[2] = cvtpk(s[12], s[13]); w1[3] = cvtpk(s[14], s[15]);
    pk0 = __builtin_bit_cast(bf16x8, w0); pk1 = __builtin_bit_cast(bf16x8, w1);
}

struct QState { float m, l; f32x16 o0, o1; bool mz, fresh; };

template <int SIDE>
__device__ __forceinline__ void pair(const unsigned short* pb, int tqA, int dil, int qoff, int koff, int voff, float slope2, QState& A, QState& B, unsigned ldsw, const ATT_LAS unsigned char* ldsp, int lane, float& tsacc, bool tson) {
    constexpr int NT = (2 * SIDE + 32) / 32;
    TS_T0(2)
    const int u = lane & 31, hi = lane >> 5;
    int tlo = 0, thi = NT;
    while (tqA + dil * (32 * tlo - SIDE) < 0) ++tlo;
    while (tqA + dil * (32 * thi - SIDE) >= SEQL) --thi;
    const int r8 = lane >> 3;
    const unsigned short* kbase = pb + (size_t)(tqA + dil * (r8 - SIDE)) * LD + koff + 8 * ((lane & 7) ^ (r8 >> 1));
    const unsigned short* vbase = pb + (size_t)(tqA + dil * (r8 - SIDE)) * LD + voff + 8 * ((lane & 7) ^ (4 * ((r8 >> 1) & 1)));
    const int kx = 8 * ((((lane & 7) ^ (r8 >> 1)) ^ 4) - ((lane & 7) ^ (r8 >> 1)));
    const size_t rstep = (size_t)dil * LD;
#define ATT_DMA_K(t, slot) do { const unsigned short* p_ = kbase + (size_t)(32 * (t)) * rstep; const unsigned d_ = ldsw + (slot) * 8192u; \
        glds16(p_, d_); glds16(p_ + 8 * rstep + kx, d_ + 1024u); glds16(p_ + 16 * rstep, d_ + 2048u); glds16(p_ + 24 * rstep + kx, d_ + 3072u); } while (0)
#define ATT_DMA_V(t, slot) do { const unsigned short* p_ = vbase + (size_t)(32 * (t)) * rstep; const unsigned d_ = ldsw + (slot) * 8192u + 4096u; \
        glds16(p_, d_); glds16(p_ + 8 * rstep, d_ + 1024u); glds16(p_ + 16 * rstep, d_ + 2048u); glds16(p_ + 24 * rstep, d_ + 3072u); } while (0)
    ATT_DMA_K(tlo, tlo & 1); ATT_DMA_V(tlo, tlo & 1);
    if (tlo + 1 <= thi) { ATT_DMA_K(tlo + 1, (tlo + 1) & 1); ATT_DMA_V(tlo + 1, (tlo + 1) & 1); }
    bf16x8 qa[4], qb[4];
    { const unsigned short* qp = pb + (size_t)(tqA + u * dil) * LD + qoff + 8 * hi;
#pragma unroll
      for (int d0 = 0; d0 < 4; ++d0) { qa[d0] = *(const bf16x8*)(qp + 16 * d0); qb[d0] = *(const bf16x8*)(qp + (size_t)32 * rstep + 16 * d0); } }
    asm volatile("" : "+v"(qa[0]), "+v"(qa[1]), "+v"(qa[2]), "+v"(qa[3]), "+v"(qb[0]), "+v"(qb[1]), "+v"(qb[2]), "+v"(qb[3]));
    asm volatile("" : "+v"(A.o0), "+v"(A.o1), "+v"(B.o0), "+v"(B.o1), "+v"(A.m), "+v"(A.l), "+v"(B.m), "+v"(B.l));
    TS_T1(2)
    const int sw = (u >> 1) & 7;
    const int ka0 = u * 128 + (((0 + hi) ^ sw) << 4), ka1 = u * 128 + (((2 + hi) ^ sw) << 4), ka2 = u * 128 + (((4 + hi) ^ sw) << 4), ka3 = u * 128 + (((6 + hi) ^ sw) << 4);
    const int q_ = (lane & 15) >> 2, p_ = lane & 3, g16 = (lane >> 4) & 1;
    const int vb0 = 4096 + (4 * hi + q_) * 128 + ((4 * (q_ >> 1) + 2 * g16 + (p_ >> 1)) << 4) + 8 * (p_ & 1), vb1 = vb0 ^ 64;
    { TS_T0(3)
#pragma unroll 1
    for (int t = tlo; t <= thi; ++t) {
        const ATT_LAS unsigned char* sl = ldsp + (t & 1) * 8192;
        { TS_T0(5) if (t + 1 <= thi) ATT_WAITV(12); else ATT_WAITV(4);
        TS_T1(5) }
        bf16x8 kf[4];
        kf[0] = *(const ATT_LAS bf16x8*)(sl + ka0); kf[1] = *(const ATT_LAS bf16x8*)(sl + ka1); kf[2] = *(const ATT_LAS bf16x8*)(sl + ka2); kf[3] = *(const ATT_LAS bf16x8*)(sl + ka3);
        asm volatile("s_waitcnt lgkmcnt(0)" : "+v"(kf[0]), "+v"(kf[1]), "+v"(kf[2]), "+v"(kf[3]) :: "memory");
        if (t + 2 <= thi) ATT_DMA_K(t + 2, t & 1);
        const float c0 = (float)(32 * t - SIDE + 4 * hi - u);
        bf16x8 pa0, pa1, pb0, pb1;
        const bool actA = t <= NT - 1, actB = t >= 1;
        if (actA) {
            f32x16 S;
#pragma unroll
            for (int r = 0; r < 16; ++r) S[r] = 0.f;
#pragma unroll
            for (int d0 = 0; d0 < 4; ++d0) S = __builtin_amdgcn_mfma_f32_32x32x16_bf16(kf[d0], qa[d0], S, 0, 0, 0);
            softmax_step<SIDE>(S, c0, slope2, t == 0 || t == NT - 1, A.fresh, A.m, A.l, A.o0, A.o1, A.mz, pa0, pa1); A.fresh = false;
        }
        if (actB) {
            f32x16 S;
#pragma unroll
            for (int r = 0; r < 16; ++r) S[r] = 0.f;
#pragma unroll
            for (int d0 = 0; d0 < 4; ++d0) S = __builtin_amdgcn_mfma_f32_32x32x16_bf16(kf[d0], qb[d0], S, 0, 0, 0);
            softmax_step<SIDE>(S, c0 - 32.0f, slope2, t == 1 || t == NT, B.fresh, B.m, B.l, B.o0, B.o1, B.mz, pb0, pb1); B.fresh = false;
        }
        { TS_T0(5) if (t + 2 <= thi) ATT_WAITV(12); else if (t + 1 <= thi) ATT_WAITV(8); else ATT_WAITV(0);
        TS_T1(5) }
        {
            const s16x4 a0 = vtr(sl + vb0), a1 = vtr(sl + vb0 + 1024), b0 = vtr(sl + vb0 + 2048), b1 = vtr(sl + vb0 + 3072);
            bf16x8 v00 = __builtin_shufflevector(a0, a1, 0, 1, 2, 3, 4, 5, 6, 7), v01 = __builtin_shufflevector(b0, b1, 0, 1, 2, 3, 4, 5, 6, 7);
            if (actA) { A.o0 = __builtin_amdgcn_mfma_f32_32x32x16_bf16(v00, pa0, A.o0, 0, 0, 0); A.o0 = __builtin_amdgcn_mfma_f32_32x32x16_bf16(v01, pa1, A.o0, 0, 0, 0); }
            if (actB) { B.o0 = __builtin_amdgcn_mfma_f32_32x32x16_bf16(v00, pb0, B.o0, 0, 0, 0); B.o0 = __builtin_amdgcn_mfma_f32_32x32x16_bf16(v01, pb1, B.o0, 0, 0, 0); }
        }
        {
            const s16x4 c0_ = vtr(sl + vb1), c1 = vtr(sl + vb1 + 1024), d0_ = vtr(sl + vb1 + 2048), d1 = vtr(sl + vb1 + 3072);
            bf16x8 v10 = __builtin_shufflevector(c0_, c1, 0, 1, 2, 3, 4, 5, 6, 7), v11 = __builtin_shufflevector(d0_, d1, 0, 1, 2, 3, 4, 5, 6, 7);
            asm volatile("s_waitcnt lgkmcnt(0)" : "+v"(v10), "+v"(v11) :: "memory");
            if (t + 2 <= thi) ATT_DMA_V(t + 2, t & 1);
            if (actA) { A.o1 = __builtin_amdgcn_mfma_f32_32x32x16_bf16(v10, pa0, A.o1, 0, 0, 0); A.o1 = __builtin_amdgcn_mfma_f32_32x32x16_bf16(v11, pa1, A.o1, 0, 0, 0); }
            if (actB) { B.o1 = __builtin_amdgcn_mfma_f32_32x32x16_bf16(v10, pb0, B.o1, 0, 0, 0); B.o1 = __builtin_amdgcn_mfma_f32_32x32x16_bf16(v11, pb1, B.o1, 0, 0, 0); }
        }
    }
    TS_T1(3) }
#undef ATT_DMA_K
#undef ATT_DMA_V
}
__device__ __forceinline__ void finish(const QState& Q, unsigned short* yrow, float* ssyp, int hi) {
    const float lt = Q.l + __shfl_xor(Q.l, 32), inv = 1.0f / lt; float sq = 0.f;
#pragma unroll
    for (int g = 0; g < 4; ++g) {
        const float a0 = Q.o0[4 * g] * inv, a1 = Q.o0[4 * g + 1] * inv, a2 = Q.o0[4 * g + 2] * inv, a3 = Q.o0[4 * g + 3] * inv;
        const float b0 = Q.o1[4 * g] * inv, b1 = Q.o1[4 * g + 1] * inv, b2 = Q.o1[4 * g + 2] * inv, b3 = Q.o1[4 * g + 3] * inv;
        sq += ((a0 * a0 + a1 * a1) + (a2 * a2 + a3 * a3)) + ((b0 * b0 + b1 * b1) + (b2 * b2 + b3 * b3));
        u32x2 wa, wb; wa[0] = cvtpk(a0, a1); wa[1] = cvtpk(a2, a3); wb[0] = cvtpk(b0, b1); wb[1] = cvtpk(b2, b3);
        *(u32x2*)(yrow + 8 * g + 4 * hi) = wa; *(u32x2*)(yrow + 32 + 8 * g + 4 * hi) = wb;
    }
    sq += __shfl_xor(sq, 32);
    if (hi == 0) *ssyp = sq;
}
__device__ __forceinline__ void st_load(QState& Q, const float* stO, const float* stML, int ts, int hi) {
    const f32x2_t ml = *(const f32x2_t*)(stML + 2 * ts); Q.m = ml[0]; Q.l = hi == 0 ? ml[1] : 0.f; Q.mz = !__any(ml[0] != 0.f); Q.fresh = false;
#pragma unroll
    for (int g = 0; g < 4; ++g) { const f32x4 a = *(const f32x4*)(stO + ts * 64 + 8 * g + 4 * hi), c = *(const f32x4*)(stO + ts * 64 + 32 + 8 * g + 4 * hi);
        Q.o0[4 * g] = a[0]; Q.o0[4 * g + 1] = a[1]; Q.o0[4 * g + 2] = a[2]; Q.o0[4 * g + 3] = a[3]; Q.o1[4 * g] = c[0]; Q.o1[4 * g + 1] = c[1]; Q.o1[4 * g + 2] = c[2]; Q.o1[4 * g + 3] = c[3]; }
}
__device__ __forceinline__ void st_save(const QState& Q, float* stO, float* stML, int ts, int hi) {
    const float lt = Q.l + __shfl_xor(Q.l, 32);
    if (hi == 0) { f32x2_t ml; ml[0] = Q.m; ml[1] = lt; *(f32x2_t*)(stML + 2 * ts) = ml; }
#pragma unroll
    for (int g = 0; g < 4; ++g) { f32x4 a, c; a[0] = Q.o0[4 * g]; a[1] = Q.o0[4 * g + 1]; a[2] = Q.o0[4 * g + 2]; a[3] = Q.o0[4 * g + 3]; c[0] = Q.o1[4 * g]; c[1] = Q.o1[4 * g + 1]; c[2] = Q.o1[4 * g + 2]; c[3] = Q.o1[4 * g + 3];
        *(f32x4*)(stO + ts * 64 + 8 * g + 4 * hi) = a; *(f32x4*)(stO + ts * 64 + 32 + 8 * g + 4 * hi) = c; }
}
__device__ __forceinline__ void st_init(QState& Q, float l, bool fresh) { Q.m = 0.f; Q.l = l; Q.mz = true; Q.fresh = fresh;
#pragma unroll
    for (int r = 0; r < 16; ++r) { Q.o0[r] = 0.f; Q.o1[r] = 0.f; } }
__device__ __forceinline__ void phase(const unsigned short* proj, const float* sink, unsigned short* Y, float* SSY, unsigned char* state_ws, ATT_LAS unsigned char* lds, int vcu, int G, float* tsw) {
    constexpr int NB = 8, NITEM = 2 * NB * 8 * (SEQL / SPAN);
    int tid_ = threadIdx.x; asm volatile("" : "+v"(tid_));
    const int lane = tid_ & 63, wave = __builtin_amdgcn_readfirstlane(tid_ >> 6), u = lane & 31, hi = lane >> 5;
    const ATT_LAS unsigned char* ldsp = lds + wave * 16384;
    const unsigned ldsw = (unsigned)__builtin_amdgcn_readfirstlane((int)(unsigned)(uintptr_t)ldsp);
    float* stO = (float*)(state_ws + (size_t)blockIdx.x * ST_BYTES); float* stML = stO + SPAN * 64;
    float tsacc = 0.f; const bool tson0 = TS_PROBE != 0 && vcu == 1 && wave == 0;
    for (int it = vcu; it < NITEM; it += G)
    for (int rep_ = 0; rep_ < ((ATT_PROBE == 3 && it >= NITEM / 2) || (ATT_PROBE == 4 && it < NITEM / 2) ? 2 : 1); ++rep_) {
        const bool dg = it < NITEM / 2; const int id = dg ? it : it - NITEM / 2;
        const int span = id & 3, h = (id >> 2) & 7, b = id >> 5, tok0 = span * SPAN, h16 = dg ? h : 8 + h;
        const unsigned short* pb = proj + (size_t)b * SEQL * LD;
        const float slope = __builtin_amdgcn_exp2f(-0.5f * (float)((dg ? 8 + h : h) + 1)) * 1.4426950408889634f;
        if (dg) {
            const bool tson = tson0 && TS_PROBE < 10; TS_T0(1)
            const int qoff = h * 64, koff = 512 + h * 64, voff = 1024 + h * 64;
#pragma unroll 1
            for (int pass = 0; pass < 3; ++pass) {
                const int dil = pass == 0 ? 16 : (pass == 1 ? 4 : 1);
#pragma unroll 1
                for (int k = 0; k < 2; ++k) {
                    const int p = wave + 8 * k;
                    const int tqA = tok0 + (pass == 0 ? p : (pass == 1 ? 256 * (p >> 2) + (p & 3) : 64 * p));
                    const int tsA = tqA - tok0 + u * dil, tsB = tsA + 32 * dil;
                    QState A, B;
                    if (pass == 0) { st_init(A, 0.f, true); st_init(B, 0.f, true); }
                    else { TS_T0(6) st_load(A, stO, stML, tsA, hi); st_load(B, stO, stML, tsB, hi); asm volatile("" : "+v"(A.o0), "+v"(A.o1), "+v"(B.o0), "+v"(B.o1)); TS_T1(6) }
                    pair<64>(pb, tqA, dil, qoff, koff, voff, slope * (float)dil, A, B, ldsw, ldsp, lane, tsacc, tson && TS_PROBE < 10);
#if ATT_PROBE == 1
                    { QState A2 = A, B2 = B; pair<64>(pb, tqA, dil, qoff, koff, voff, slope * (float)dil, A2, B2, ldsw, ldsp, lane, tsacc, false);
                      float sm = A2.m + A2.l + B2.m + B2.l;
#pragma unroll
                      for (int r = 0; r < 16; ++r) sm += A2.o0[r] + A2.o1[r] + B2.o0[r] + B2.o1[r];
                      if (sm == 12345.678f) stML[0] = sm; }
#endif
#if ATT_PROBE == 2
                    if (pass < 2) { st_save(A, stO, stML, tsA, hi); st_save(B, stO, stML, tsB, hi); asm volatile("s_waitcnt vmcnt(0)" ::: "memory"); st_load(A, stO, stML, tsA, hi); st_load(B, stO, stML, tsB, hi); A.l = A.l + __shfl_xor(A.l, 32) * 0.f; }
#endif
                    if (pass < 2) { TS_T0(7) st_save(A, stO, stML, tsA, hi); st_save(B, stO, stML, tsB, hi); if (TS_PROBE == 7) asm volatile("s_waitcnt vmcnt(0)" ::: "memory"); TS_T1(7) }
                    else { TS_T0(4) const size_t tok = (size_t)b * SEQL + tqA + u; finish(A, Y + tok * 1024 + h16 * 64, SSY + tok * 16 + h16, hi); finish(B, Y + (tok + 32) * 1024 + h16 * 64, SSY + (tok + 32) * 16 + h16, hi); if (TS_PROBE == 4) asm volatile("s_waitcnt vmcnt(0)" ::: "memory"); TS_T1(4) }
                }
                { TS_T0(8) __syncthreads(); TS_T1(8) }
            }
            TS_T1(1)
        } else {
            const bool tson = tson0 && TS_PROBE >= 10; TS_T0(1)
            const int qoff = 1536 + h * 64, koff = 2048 + (h >> 2) * 64, voff = 2176 + (h >> 2) * 64;
            const float sk2 = sink[h] * 1.4426950408889634f;
#pragma unroll 1
            for (int k = 0; k < 2; ++k) {
                const int tqA = tok0 + 64 * (wave + 8 * k);
                const float lsink = hi == 0 ? __builtin_amdgcn_exp2f(sk2) : 0.f;
                QState A, B; st_init(A, lsink, false); st_init(B, lsink, false);
                pair<128>(pb, tqA, 1, qoff, koff, voff, slope, A, B, ldsw, ldsp, lane, tsacc, tson && TS_PROBE >= 10);
#if ATT_PROBE == 1
                { QState A2 = A, B2 = B; pair<128>(pb, tqA, 1, qoff, koff, voff, slope, A2, B2, ldsw, ldsp, lane, tsacc, false);
                  float sm = A2.m + A2.l + B2.m + B2.l;
#pragma unroll
                  for (int r = 0; r < 16; ++r) sm += A2.o0[r] + A2.o1[r] + B2.o0[r] + B2.o1[r];
                  if (sm == 12345.678f) stML[0] = sm; }
#endif
                { TS_T0(4) const size_t tok = (size_t)b * SEQL + tqA + u; finish(A, Y + tok * 1024 + h16 * 64, SSY + tok * 16 + h16, hi); finish(B, Y + (tok + 32) * 1024 + h16 * 64, SSY + (tok + 32) * 16 + h16, hi); if (TS_PROBE == 14) asm volatile("s_waitcnt vmcnt(0)" ::: "memory"); TS_T1(4) }
            }
            TS_T1(1)
        }
    }
    if (TS_PROBE != 0 && tson0 && lane == 0) atomicAdd(tsw, tsacc);
    __syncthreads();
}
#undef ATT_LAS
}

struct Frame {
    LAS unsigned char* lds;
    volatile LAS unsigned* MISC;
    gu32* ctl;
    int tid, lane, wave;
    int vcu, G;
};
__device__ __forceinline__ float wave_sum(float v) {
#pragma unroll
    for (int o = 1; o < 64; o <<= 1) v += __shfl_xor(v, o);
    return v;
}
__device__ __forceinline__ void p0_item(const float* W, int K, int N, bf16* WT, int out_row0, const float* gk, float nscale, LAS float* scr, int k0, int n0, int lane) {
    float wv[32];
#pragma unroll
    for (int i = 0; i < 32; ++i) wv[i] = W[(size_t)(k0 + 2 * i + (lane >> 5)) * N + n0 + (lane & 31)];
    float gv[32];
#pragma unroll
    for (int i = 0; i < 32; ++i) gv[i] = gk ? gk[k0 + 2 * i + (lane >> 5)] * nscale : nscale;
#pragma unroll
    for (int i = 0; i < 32; ++i) scr[(2 * i + (lane >> 5)) * 33 + (lane & 31)] = wv[i] * gv[i];
    LDS_WAIT(); asm volatile("" ::: "memory");
    const int c = lane & 7;
#pragma unroll
    for (int j = 0; j < 4; ++j) { const int n = (lane >> 3) + 8 * j; const LAS float* s = scr + (8 * c) * 33 + n;
        v4u o; o.x = pk2(s[0 * 33], s[1 * 33]); o.y = pk2(s[2 * 33], s[3 * 33]); o.z = pk2(s[4 * 33], s[5 * 33]); o.w = pk2(s[6 * 33], s[7 * 33]);
        *(GAS v4u*)(WT + (size_t)(out_row0 + n) * K + k0 + 8 * c) = o; }
    LDS_WAIT(); asm volatile("" ::: "memory");
}
struct Ptrs {
    const float *x, *g_mix, *w_in, *g_out_dil, *g_out_win, *sink, *w_out, *g_ffn, *w_gate, *w_up, *w_down, *g_final;
    float* out; unsigned char* ws;
};
__device__ __forceinline__ void p0_prologue(Frame& F0, const Ptrs& P) {
    Frame F = F0; { int t_ = threadIdx.x; asm volatile("" : "+v"(t_)); F.tid = t_; F.lane = t_ & 63; F.wave = __builtin_amdgcn_readfirstlane(t_ >> 6); }
    LAS float* scr = (LAS float*)(F.lds + RING_OFF + F.wave * 16384);
    const int gw = F.vcu * NWAVES + F.wave, NGW = F.G * NWAVES;
    constexpr int I_IN = (D / 64) * (IN_COLS / 32), I_OUT = (D / 64) * (D / 32), I_G = (D / 64) * (FF / 32), I_D = (FF / 64) * (D / 32);
    constexpr int I_LAYER = I_IN + I_OUT + 2 * I_G + I_D;
    for (int it = gw; it < DEPTH * I_LAYER; it += NGW) {
        const int L = it / I_LAYER; int r = it % I_LAYER;
        bf16* wl = (bf16*)(P.ws + WS_W + (size_t)L * W_LAYER);
        if (r < I_IN) { const int nblk = IN_COLS / 32, kb = r / nblk, nb = r % nblk, n0 = 32 * nb; const bool isq = (n0 < 512) || (n0 >= 1536 && n0 < 2048);
            p0_item(P.w_in + (size_t)L * D * IN_COLS, D, IN_COLS, (bf16*)((unsigned char*)wl + W_IN), n0, P.g_mix + L * D, isq ? C2 : 1.0f, scr, 64 * kb, n0, F.lane); continue; } r -= I_IN;
        if (r < I_OUT) { const int nblk = D / 32, kb = r / nblk, nb = r % nblk, n0 = 32 * nb, k0 = 64 * kb;
            const float* gk = (k0 < 512) ? (P.g_out_dil + L * 512) : (P.g_out_win + L * 512 - 512);
            p0_item(P.w_out + (size_t)L * D * D, D, D, (bf16*)((unsigned char*)wl + W_OUT), n0, gk, 1.0f, scr, k0, n0, F.lane); continue; } r -= I_OUT;
        if (r < 2 * I_G) { const bool up = r >= I_G; if (up) r -= I_G; const int nblk = FF / 32, kb = r / nblk, nb = r % nblk, n0 = 32 * nb;
            const int orow = 256 * (n0 / 128) + (up ? 128 : 0) + (n0 % 128);
            p0_item((up ? P.w_up : P.w_gate) + (size_t)L * D * FF, D, FF, (bf16*)((unsigned char*)wl + W_GU), orow, P.g_ffn + L * D, 1.0f, scr, 64 * kb, n0, F.lane); continue; } r -= 2 * I_G;
        { const int nblk = D / 32, kb = r / nblk, nb = r % nblk, n0 = 32 * nb;
            p0_item(P.w_down + (size_t)L * FF * D, FF, D, (bf16*)((unsigned char*)wl + W_DOWN), n0, nullptr, 1.0f, scr, 64 * kb, n0, F.lane); }
    }
    bf16* XB = (bf16*)(P.ws + WS_XB); float* ss = (float*)(P.ws + WS_SS_MIX);
    for (int m0 = gw; m0 < M; m0 += 4 * NGW) {
        f32x4 v[4][4];
#pragma unroll
        for (int r = 0; r < 4; ++r) { const int m = m0 + r * NGW; if (m < M) { const GAS f32x4* xr = (const GAS f32x4*)(P.x + (size_t)m * D) + F.lane;
#pragma unroll
            for (int j = 0; j < 4; ++j) v[r][j] = xr[64 * j]; } }
#pragma unroll
        for (int r = 0; r < 4; ++r) { const int m = m0 + r * NGW; if (m < M) { float s = 0.f;
#pragma unroll
            for (int j = 0; j < 4; ++j) s += (v[r][j].x * v[r][j].x + v[r][j].y * v[r][j].y) + (v[r][j].z * v[r][j].z + v[r][j].w * v[r][j].w);
            s = wave_sum(s);
            GAS unsigned long long* o8 = (GAS unsigned long long*)(XB + (size_t)m * D) + F.lane;
#pragma unroll
            for (int j = 0; j < 4; ++j) o8[64 * j] = (unsigned long long)pk2(v[r][j].x, v[r][j].y) | ((unsigned long long)pk2(v[r][j].z, v[r][j].w) << 32);
            if (F.lane < 16) ss[(size_t)m * 16 + F.lane] = (F.lane == 0) ? s : 0.f; } }
    }
}
__device__ __forceinline__ void final_norm(Frame& F0, const Ptrs& P) {
    Frame F = F0; { int t_ = threadIdx.x; asm volatile("" : "+v"(t_)); F.tid = t_; F.lane = t_ & 63; F.wave = __builtin_amdgcn_readfirstlane(t_ >> 6); }
    const int gw = F.vcu * NWAVES + F.wave, NGW = F.G * NWAVES; const float* ss = (const float*)(P.ws + WS_SS_MIX); const bf16* XB = (const bf16*)(P.ws + WS_XB);
    f32x4 g[4];
#pragma unroll
    for (int j = 0; j < 4; ++j) g[j] = ((const GAS f32x4*)P.g_final)[F.lane + 64 * j];
    for (int m0 = gw; m0 < M; m0 += 4 * NGW) {
        unsigned long long w[4][4]; float rsv[4];
#pragma unroll
        for (int r = 0; r < 4; ++r) { const int m = m0 + r * NGW; if (m < M) { const GAS unsigned long long* xr = (const GAS unsigned long long*)(XB + (size_t)m * D) + F.lane;
#pragma unroll
            for (int j = 0; j < 4; ++j) w[r][j] = xr[64 * j];
            rsv[r] = pg8::ss_row_sum(ss, m); } }
#pragma unroll
        for (int r = 0; r < 4; ++r) { const int m = m0 + r * NGW; if (m < M) { GAS f32x4* orow = (GAS f32x4*)(P.out + (size_t)m * D) + F.lane;
            const float rs = __builtin_amdgcn_rsqf(rsv[r] * (1.0f / 1024.0f) + EPS);
#pragma unroll
            for (int j = 0; j < 4; ++j) { const unsigned lo = (unsigned)w[r][j], hi = (unsigned)(w[r][j] >> 32);
                f32x4 v; v.x = __uint_as_float(lo << 16); v.y = __uint_as_float(lo & 0xffff0000u); v.z = __uint_as_float(hi << 16); v.w = __uint_as_float(hi & 0xffff0000u);
                orow[64 * j] = v * rs * g[j]; } } }
    }
#if defined(TS_PROBE) && TS_PROBE != 0
    if (F.vcu == 1 && F.wave == 0 && F.lane == 0) P.out[(size_t)8 * D] = TS_SCALE * __hip_atomic_load((float*)(P.ws + WS_CTL) + 2048, __ATOMIC_RELAXED, __HIP_MEMORY_SCOPE_AGENT);
#endif
}
template <int MODE> __device__ __forceinline__ void rs_prepass(const pg8::StaticOrder& S, const float* ss, LAS float* tab) {
    int tid = threadIdx.x; asm volatile("" : "+v"(tid));
    pg8::Unit u;
    for (int i = 0; i < TAB_UNITS && S.next(i, u); ++i)
        for (int r = tid; r < 256; r += NWAVES * 64) { const int row = u.pm * 256 + r;
            const f32x4* p = (const f32x4*)(ss + (size_t)row * 16); const f32x4 a = p[0], b = p[1], c = p[2], d = p[3];
            const float s0 = ((a[0] + a[1]) + (a[2] + a[3])) + ((b[0] + b[1]) + (b[2] + b[3])), s1 = ((c[0] + c[1]) + (c[2] + c[3])) + ((d[0] + d[1]) + (d[2] + d[3]));
            if (MODE == 0) tab[i * 256 + r] = __builtin_amdgcn_rsqf((s0 + s1) * (1.0f / 1024.0f) + EPS);
            else { const float ra = __builtin_amdgcn_rsqf(s0 * (1.0f / 512.0f) + EPS), rb = __builtin_amdgcn_rsqf(s1 * (1.0f / 512.0f) + EPS); pg8::f32x2 v; v[0] = ra * __builtin_amdgcn_rcpf(rb); v[1] = rb; ((LAS pg8::f32x2*)tab)[i * 256 + r] = v; } }
    __syncthreads();
}

struct Args { const float* in[12]; float* out; unsigned char* ws; int ph_lo, ph_hi, li, pad; };
__global__ void __launch_bounds__(NWAVES * 64, 2) mk_fwd(Args args) {
    extern __shared__ __attribute__((aligned(16))) unsigned char lds[];
    Frame F;
    F.lds = (LAS unsigned char*)lds;
    F.MISC = (volatile LAS unsigned*)(F.lds + MISC_OFF);
    F.tid = threadIdx.x; F.lane = F.tid & 63; F.wave = __builtin_amdgcn_readfirstlane(F.tid >> 6);
    F.G = gridDim.x; { const int bx = blockIdx.x; F.vcu = (F.G % 8 == 0) ? (bx % 8) * (F.G / 8) + bx / 8 : bx; }
    unsigned char* ws = args.ws;
    F.ctl = (gu32*)(ws + WS_CTL);
    Ptrs P; P.x = args.in[0]; P.g_mix = args.in[1]; P.w_in = args.in[2]; P.g_out_dil = args.in[3]; P.g_out_win = args.in[4]; P.sink = args.in[5]; P.w_out = args.in[6];
    P.g_ffn = args.in[7]; P.w_gate = args.in[8]; P.w_up = args.in[9]; P.w_down = args.in[10]; P.g_final = args.in[11]; P.out = args.out; P.ws = ws;
    for (int u = F.tid; u < (LDS_BYTES - LDSCTL_OFF) / 4; u += NWAVES * 64) ((LAS unsigned*)(F.lds + LDSCTL_OFF))[u] = 0u;
    __syncthreads();
    XcdBarrier bar; bar.bar = (unsigned*)(F.ctl + CW_BAR); bar.x = 0; bar.st = nullptr;
    if (MK_ONE_LAUNCH) bar = xcd_barrier_post((unsigned*)(F.ctl + CW_BAR), F.MISC + 8);
    const int lo = args.ph_lo, hi = args.ph_hi;
#define IN(k) (lo <= (k) && (k) < hi)
#if defined(TS_PROBE) && TS_PROBE >= 100
#define PH_T0(k) unsigned long long pt0_ = 0; if (TS_PROBE - 100 == (k) && F.vcu == 1 && threadIdx.x == 0) pt0_ = __builtin_amdgcn_s_memrealtime();
#define PH_T1(k) if (TS_PROBE - 100 == (k) && F.vcu == 1 && threadIdx.x == 0) atomicAdd((float*)(ws + WS_CTL) + 2048, (float)(__builtin_amdgcn_s_memrealtime() - pt0_));
#else
#define PH_T0(k)
#define PH_T1(k)
#endif
#define SEAM(k) do { if (MK_ONE_LAUNCH && IN(k) && IN((k) + 1)) xcd_barrier(bar); } while (0)
    bf16* XB = (bf16*)(ws + WS_XB); bf16* PROJ = (bf16*)(ws + WS_PROJ); bf16* Y = (bf16*)(ws + WS_Y); bf16* ACT = (bf16*)(ws + WS_ACT);
    float* SS_MIX = (float*)(ws + WS_SS_MIX); float* SSY = (float*)(ws + WS_SSY); float* SS_FFN = (float*)(ws + WS_SS_FFN); LAS float* TAB = (LAS float*)(F.lds + TAB_OFF);

    { PH_T0(0) if (IN(0)) { p0_prologue(F, P); if (MK_DUP == 9) p0_prologue(F, P); } SEAM(0); PH_T1(0) }
    for (int L = 0; L < DEPTH; ++L) {
        const int pb = 1 + 5 * L;
        const unsigned char* wl = ws + WS_W + (size_t)L * W_LAYER;
        { PH_T0(pb)
        for (int rep_ = 0; rep_ < (MK_DUP == 0 ? 2 : 1); ++rep_)
        if (IN(pb)) {
            pg8::Gemm g{XB, (const bf16*)(wl + W_IN), M, IN_COLS, D}; pg8::StaticOrder S; S.init(M, IN_COLS, F.G, (int)blockIdx.x);
            rs_prepass<0>(S, SS_MIX, TAB); pg8::EpiProj E{PROJ, IN_COLS, TAB};
            pg8::gemm_phase<pg8::EpiProj, pg8::StaticOrder, true, true>(F.lds + RING_OFF, g, S, E);
        } SEAM(pb); PH_T1(pb) }
        { PH_T0(pb + 1)
        for (int rep_ = 0; rep_ < (MK_DUP == 1 ? 2 : 1); ++rep_)
        if (IN(pb + 1)) { att::phase(PROJ, P.sink + L * 8, Y, SSY, ws + WS_ATT, F.lds + RING_OFF, F.vcu, F.G, (float*)(ws + WS_CTL) + 2048); } SEAM(pb + 1); PH_T1(pb + 1) }
        { PH_T0(pb + 2)
        for (int rep_ = 0; rep_ < ((MK_DUP == 2 && L == 0) ? 2 : 1); ++rep_)
        if (IN(pb + 2)) {
            pg8::Gemm g{Y, (const bf16*)(wl + W_OUT), M, D, D}; pg8::StaticOrder S; S.init(M, D, F.G, (int)blockIdx.x);
            rs_prepass<1>(S, SSY, TAB); pg8::EpiRes<true> E{XB, SS_FFN, (const LAS pg8::f32x2*)TAB};
            pg8::gemm_phase<pg8::EpiRes<true>, pg8::StaticOrder, true, true>(F.lds + RING_OFF, g, S, E);
        } SEAM(pb + 2); PH_T1(pb + 2) }
        { PH_T0(pb + 3)
        for (int rep_ = 0; rep_ < (MK_DUP == 3 ? 2 : 1); ++rep_)
        if (IN(pb + 3)) {
            pg8::Gemm g{XB, (const bf16*)(wl + W_GU), M, GU, D}; pg8::StaticOrder S; S.init(M, GU, F.G, (int)blockIdx.x);
            rs_prepass<0>(S, SS_FFN, TAB); pg8::EpiSwiglu E{ACT, FF, TAB};
            pg8::gemm_phase<pg8::EpiSwiglu, pg8::StaticOrder, true, true>(F.lds + RING_OFF, g, S, E);
        } SEAM(pb + 3); PH_T1(pb + 3) }
        { PH_T0(pb + 4)
        if (IN(pb + 4)) {
            pg8::Gemm g{ACT, (const bf16*)(wl + W_DOWN), M, D, FF}; pg8::StaticOrder S; S.init(M, D, F.G, (int)blockIdx.x);
            pg8::EpiRes<false> E{XB, SS_MIX, nullptr};
            pg8::gemm_phase<pg8::EpiRes<false>, pg8::StaticOrder, true, true>(F.lds + RING_OFF, g, S, E);
        } SEAM(pb + 4); PH_T1(pb + 4) }
    }
    if (IN(11)) { final_norm(F, P); }
#undef IN
#undef SEAM
}

extern "C" void kernel_launch(void* const* d_in, const int* in_sizes, int n_in, void* d_out, int out_size, void* d_ws, size_t ws_size, hipStream_t stream) {
    static int grid = 0;
    if (grid == 0) {
        if (n_in != 12 || in_sizes[0] != M * D || out_size != M * D || ws_size < WS_END) { fprintf(stderr, "kernel_launch: unexpected sizes (n_in %d, in0 %d, out %d, ws %zu); nothing launched\n", n_in, n_in > 0 ? in_sizes[0] : -1, out_size, ws_size); grid = -1; return; }
        int dev = 0, cus = 0, per_cu = 0;
        if (hipGetDevice(&dev) != hipSuccess || hipDeviceGetAttribute(&cus, hipDeviceAttributeMultiprocessorCount, dev) != hipSuccess) { fprintf(stderr, "kernel_launch: device query failed\n"); grid = -1; return; }
        if (hipFuncSetAttribute((const void*)mk_fwd, hipFuncAttributeMaxDynamicSharedMemorySize, LDS_BYTES) != hipSuccess) { fprintf(stderr, "kernel_launch: hipFuncSetAttribute failed\n"); grid = -1; return; }
        if (hipOccupancyMaxActiveBlocksPerMultiprocessor(&per_cu, (const void*)mk_fwd, NWAVES * 64, LDS_BYTES) != hipSuccess || per_cu < 1) { fprintf(stderr, "kernel_launch: occupancy query reports %d workgroups per CU\n", per_cu); (void)hipGetLastError(); grid = -1; return; }
        grid = cus;
        if ((long)grid * TAB_UNITS < (long)(M / 256) * (GU / 256)) { fprintf(stderr, "kernel_launch: %d workgroups cannot hold the per-unit row-scale tables of the gate/up phase in LDS\n", grid); grid = -1; return; }
    }
    if (grid < 0) return;
    if (hipMemsetAsync((char*)d_ws + WS_CTL, 0, CTL_ZERO_BYTES, stream) != hipSuccess) { fprintf(stderr, "kernel_launch: memset failed\n"); return; }
    Args a{};
    for (int i = 0; i < 12; ++i) a.in[i] = (const float*)d_in[i];
    a.out = (float*)d_out; a.ws = (unsigned char*)d_ws;
#if MK_ONE_LAUNCH
    a.ph_lo = 0; a.ph_hi = NPHASE; a.li = 0;
    hipLaunchKernelGGL(mk_fwd, dim3(grid), dim3(NWAVES * 64), LDS_BYTES, stream, a);
#else
    for (int p = 0; p < NPHASE; ++p) { a.ph_lo = p; a.ph_hi = p + 1; a.li = p; hipLaunchKernelGGL(mk_fwd, dim3(grid), dim3(NWAVES * 64), LDS_BYTES, stream, a); }
#endif
    const hipError_t le = hipPeekAtLastError();
    if (le != hipSuccess) fprintf(stderr, "kernel_launch: launch failed: %s\n", hipGetErrorName(le));
}
```

```cpp
#define MK_ONE_LAUNCH 1
#include <hip/hip_runtime.h>
#include <cstdio>
#include <cstdint>
namespace pg8 {
#define PG8_LAS __attribute__((address_space(3)))
typedef unsigned short bf16_t;
typedef short bf16x8 __attribute__((ext_vector_type(8)));
typedef float f32x4 __attribute__((ext_vector_type(4)));
typedef unsigned u32x4 __attribute__((ext_vector_type(4)));
constexpr int BM = 256, BK = 64, HALF = 128, HTB = HALF * BK * 2  , STAGE_BYTES = 8 * HTB, NXCD = 8, WGM = 8;

__host__ __device__ __forceinline__ int lds_byte(int r, int c) { const int st = (r >> 4) * 2 + (c >> 5), rr = r & 15, cc = c & 31, ob = rr * 64 + cc * 2; return st * 1024 + (ob ^ (((ob >> 9) & 1) << 5)); }
__host__ __device__ __forceinline__ void stage_rc(int b, int& R, int& C) { const int st = b / 1024, sb = b % 1024, swz = sb ^ (((sb >> 9) & 1) << 5); R = (st >> 1) * 16 + swz / 64; C = (st & 1) * 32 + (swz % 64) / 2; }
__host__ __device__ __forceinline__ int perm32(int rho) { const int n = rho >> 4, i = rho & 15; return 8 * (i >> 2) + 4 * n + (i & 3); }

struct Unit { int pm, pn, idx; };
struct Gemm { const bf16_t* A; const bf16_t* Bt; int M, N, K; };

struct StaticOrder {
    int nM, nN, nwg, G, c;
    __host__ __device__ void init(int M, int N, int G_, int c_) { nM = M / BM; nN = N / BM; nwg = nM * nN; G = G_; c = c_; }
    __host__ __device__ bool next(int i, Unit& u) const {
        const long L = (long)i * G + c; if (L >= nwg) return false;
        int wgid = (int)L; { const int q = nwg / NXCD, r = nwg % NXCD, xcd = wgid % NXCD, off = wgid / NXCD; wgid = (xcd < r ? xcd * (q + 1) : r * (q + 1) + (xcd - r) * q) + off; }
        const int nig = WGM * nN, gid = wgid / nig, fm = gid * WGM, gsz = (nM - fm) < WGM ? (nM - fm) : WGM;
        u.pm = fm + ((wgid % nig) % gsz); u.pn = (wgid % nig) / gsz; u.idx = i; return true;
    }
    __device__ __forceinline__ void a_ready(const Unit&) const {}
    __device__ __forceinline__ void done(const Unit&) const {}
};


__device__ __forceinline__ unsigned cvt_pk_bf16(float lo, float hi) { unsigned r; asm volatile("v_cvt_pk_bf16_f32 %0, %1, %2" : "=v"(r) : "v"(lo), "v"(hi)); return r; }
typedef float f32x2 __attribute__((ext_vector_type(2)));
#ifndef EPI_WT
#define EPI_WT 1
#endif
__device__ __forceinline__ void st16(void* p, u32x4 v) {
#if EPI_WT
    asm volatile("global_store_dwordx4 %0, %1, off sc1\n\ts_nop 1" :: "v"(p), "v"(v) : "memory");
#else
    *(u32x4*)p = v;
#endif
}
typedef unsigned u32x2 __attribute__((ext_vector_type(2)));
constexpr int NSS = 16;
__device__ __forceinline__ float ss_row_sum(const float* ss, int row) {
    const f32x4* p = (const f32x4*)(ss + (size_t)row * NSS);
    const f32x4 a = p[0], b = p[1], c = p[2], d = p[3];
    return ((a[0] + a[1]) + (a[2] + a[3])) + ((b[0] + b[1]) + (b[2] + b[3])) + ((c[0] + c[1]) + (c[2] + c[3])) + ((d[0] + d[1]) + (d[2] + d[3]));
}
struct EpiProj {
    static constexpr bool PERM = true, AFTER_DRAIN = false, MID = false; static constexpr int MID_T = -1;
    bf16_t* O; int ldc; const PG8_LAS float* rs_tab;
    __device__ __forceinline__ void mid(f32x4 (&acc)[2][2][4][2], const Unit& u, int wr, int wc, int fr, int fq) const {}
    __device__ __forceinline__ void operator()(const f32x4 (&acc)[2][2][4][2], const Unit& u, int wr, int wc, int fr, int fq) const {
        const int row0 = u.pm * BM + wr * 64 + fr, col0 = u.pn * BM + wc * 32 + 8 * fq;
        float rsv[2][4];
#pragma unroll
        for (int ai = 0; ai < 2; ++ai)
#pragma unroll
            for (int m = 0; m < 4; ++m) rsv[ai][m] = rs_tab[u.idx * BM + wr * 64 + fr + ai * HALF + m * 16];
#pragma unroll
        for (int ai = 0; ai < 2; ++ai)
#pragma unroll
            for (int m = 0; m < 4; ++m) { const int row = row0 + ai * HALF + m * 16;
                const float rs = rsv[ai][m];
                bf16_t* rowp = O + (size_t)row * ldc + col0;
#pragma unroll
                for (int bj = 0; bj < 2; ++bj) { const f32x4 v0 = acc[ai][bj][m][0] * rs, v1 = acc[ai][bj][m][1] * rs;
                    u32x4 w; w.x = cvt_pk_bf16(v0[0], v0[1]); w.y = cvt_pk_bf16(v0[2], v0[3]); w.z = cvt_pk_bf16(v1[0], v1[1]); w.w = cvt_pk_bf16(v1[2], v1[3]);
                    st16(rowp + bj * HALF, w); } }
    }
};
struct EpiSwiglu {
    static constexpr bool PERM = true, AFTER_DRAIN = false, MID = false; static constexpr int MID_T = -1;
    bf16_t* O; int ldc; const PG8_LAS float* rs_tab;
    __device__ __forceinline__ void mid(f32x4 (&acc)[2][2][4][2], const Unit& u, int wr, int wc, int fr, int fq) const {}
    __device__ __forceinline__ float act1(float g, float up, float rs) const { const float z = g * rs; return z * __builtin_amdgcn_rcpf(1.0f + __builtin_amdgcn_exp2f(z * -1.4426950408889634f)) * (up * rs); }
    __device__ __forceinline__ void operator()(const f32x4 (&acc)[2][2][4][2], const Unit& u, int wr, int wc, int fr, int fq) const {
        const int row0 = u.pm * BM + wr * 64 + fr, col0 = u.pn * HALF + wc * 32 + 8 * fq;
        float rsv[2][4];
#pragma unroll
        for (int ai = 0; ai < 2; ++ai)
#pragma unroll
            for (int m = 0; m < 4; ++m) rsv[ai][m] = rs_tab[u.idx * BM + wr * 64 + fr + ai * HALF + m * 16];
#pragma unroll
        for (int ai = 0; ai < 2; ++ai)
#pragma unroll
            for (int m = 0; m < 4; ++m) { const int row = row0 + ai * HALF + m * 16;
                const float rs = rsv[ai][m];
                const f32x4 g0 = acc[ai][0][m][0], g1 = acc[ai][0][m][1], u0 = acc[ai][1][m][0], u1 = acc[ai][1][m][1];
                u32x4 w; w.x = cvt_pk_bf16(act1(g0[0], u0[0], rs), act1(g0[1], u0[1], rs)); w.y = cvt_pk_bf16(act1(g0[2], u0[2], rs), act1(g0[3], u0[3], rs));
                w.z = cvt_pk_bf16(act1(g1[0], u1[0], rs), act1(g1[1], u1[1], rs)); w.w = cvt_pk_bf16(act1(g1[2], u1[2], rs), act1(g1[3], u1[3], rs));
                st16(O + (size_t)row * ldc + col0, w); }
    }
};
template <bool YSCALE> struct EpiRes {
    static constexpr bool PERM = true, AFTER_DRAIN = false, MID = YSCALE; static constexpr int MID_T = 8;
    bf16_t* xb; float* ssout; const PG8_LAS f32x2* ys;
    __device__ __forceinline__ void mid(f32x4 (&acc)[2][2][4][2], const Unit& u, int wr, int wc, int fr, int fq) const {
        if constexpr (YSCALE) {
            const int row0 = u.pm * BM + wr * 64 + fr;
            float fv[2][4];
#pragma unroll
            for (int ai = 0; ai < 2; ++ai)
#pragma unroll
                for (int m = 0; m < 4; ++m) fv[ai][m] = ys[u.idx * BM + wr * 64 + fr + ai * HALF + m * 16][0];
#pragma unroll
            for (int ai = 0; ai < 2; ++ai)
#pragma unroll
                for (int m = 0; m < 4; ++m)
#pragma unroll
                    for (int bj = 0; bj < 2; ++bj)
#pragma unroll
                        for (int n = 0; n < 2; ++n) acc[ai][bj][m][n] *= fv[ai][m];
        }
    }
    __device__ __forceinline__ void operator()(const f32x4 (&acc)[2][2][4][2], const Unit& u, int wr, int wc, int fr, int fq) const {
        const int row0 = u.pm * BM + wr * 64 + fr, col0 = u.pn * BM + wc * 32 + 8 * fq;
        float fsv[2][4];
#pragma unroll
        for (int ai = 0; ai < 2; ++ai)
#pragma unroll
            for (int m = 0; m < 4; ++m) fsv[ai][m] = YSCALE ? ys[u.idx * BM + wr * 64 + fr + ai * HALF + m * 16][1] : 1.0f;
#pragma unroll
        for (int ai = 0; ai < 2; ++ai) {
            u32x4 res[4][2];
#pragma unroll
            for (int m = 0; m < 4; ++m)
#pragma unroll
                for (int bj = 0; bj < 2; ++bj) res[m][bj] = *(const u32x4*)(xb + (size_t)(row0 + ai * HALF + m * 16) * 1024 + col0 + bj * HALF);
#pragma unroll
            for (int m = 0; m < 4; ++m) { const int row = row0 + ai * HALF + m * 16; const float fs = fsv[ai][m];
                float q = 0.f;
#pragma unroll
                for (int bj = 0; bj < 2; ++bj) { const u32x4 bb = res[m][bj];
                    f32x4 b0, b1; b0[0] = __uint_as_float(bb[0] << 16); b0[1] = __uint_as_float(bb[0] & 0xffff0000u); b0[2] = __uint_as_float(bb[1] << 16); b0[3] = __uint_as_float(bb[1] & 0xffff0000u);
                    b1[0] = __uint_as_float(bb[2] << 16); b1[1] = __uint_as_float(bb[2] & 0xffff0000u); b1[2] = __uint_as_float(bb[3] << 16); b1[3] = __uint_as_float(bb[3] & 0xffff0000u);
                    const f32x4 o0 = b0 + acc[ai][bj][m][0] * fs, o1 = b1 + acc[ai][bj][m][1] * fs;
                    u32x4 w; w.x = cvt_pk_bf16(o0[0], o0[1]); w.y = cvt_pk_bf16(o0[2], o0[3]); w.z = cvt_pk_bf16(o1[0], o1[1]); w.w = cvt_pk_bf16(o1[2], o1[3]);
                    *(u32x4*)(xb + (size_t)row * 1024 + col0 + bj * HALF) = w;
                    q += ((o0[0] * o0[0] + o0[1] * o0[1]) + (o0[2] * o0[2] + o0[3] * o0[3])) + ((o1[0] * o1[0] + o1[1] * o1[1]) + (o1[2] * o1[2] + o1[3] * o1[3])); }
                q += __shfl_xor(q, 16); q += __shfl_xor(q, 32);
                if (fq == 0) ssout[(size_t)row * NSS + u.pn * 4 + wc] = q; }
            asm volatile("" ::: "memory");
        }
    }
};

template <class Epi, class Sched, bool ALIGN_EPI = false, bool SP2 = false>
__device__ __forceinline__ void gemm_phase(PG8_LAS unsigned char* lds, const Gemm g, const Sched& S, const Epi& E) {
    int tid_ = threadIdx.x; asm volatile("" : "+v"(tid_));
    const int tid = tid_, wid = __builtin_amdgcn_readfirstlane(tid >> 6), lane = tid & 63, wr = wid >> 2, wc = wid & 3, fr = lane & 15, fq = lane >> 4;
    const int K = g.K, nt = K / BK;
    unsigned voffA[2], voffB[2];
#pragma unroll
    for (int i = 0; i < 2; ++i) { int R, C; stage_rc(tid * 16 + i * 8192, R, C); const int Rb = Epi::PERM ? ((R & ~31) + perm32(R & 31)) : R;
        voffA[i] = (unsigned)(R * K + C) * 2u; voffB[i] = (unsigned)(Rb * K + C) * 2u; }
    const size_t kstep = (size_t)(BK * 2);
    const size_t hstep = (size_t)HALF * K * 2;
    const size_t tstep = 2 * hstep;
    const unsigned ldsw = (unsigned)wid * 1024u;
    const int aoff = lds_byte(wr * 64 + fr, fq * 8), boff = lds_byte(wc * 32 + fr, fq * 8);
#define PG8_SA(b, h) (((b) * 2 + (h)) * HTB)
#define PG8_SB(b, h) ((4 + (b) * 2 + (h)) * HTB)
#define PG8_STAGE(bufoff, gbase, voff) do { _Pragma("unroll") for (int _i = 0; _i < 2; ++_i) \
        __builtin_amdgcn_global_load_lds((const unsigned*)((const char*)(gbase) + (voff)[_i]), (PG8_LAS unsigned*)(lds + (bufoff) + ldsw + _i * 8192), 16, 0, 0); } while (0)
#define PG8_LDA(dst, b, h) do { _Pragma("unroll") for (int m = 0; m < 4; ++m) _Pragma("unroll") for (int k = 0; k < 2; ++k) dst[m][k] = *(const PG8_LAS bf16x8*)(lds + PG8_SA(b, h) + aoff + m * 2048 + k * 1024); } while (0)
#define PG8_LDB(dst, b, h) do { _Pragma("unroll") for (int n = 0; n < 2; ++n) _Pragma("unroll") for (int k = 0; k < 2; ++k) dst[n][k] = *(const PG8_LAS bf16x8*)(lds + PG8_SB(b, h) + boff + n * 2048 + k * 1024); } while (0)
#define PG8_MMA(ai, bj, At, Bt) do { __builtin_amdgcn_s_setprio(1); _Pragma("unroll") for (int m = 0; m < 4; ++m) _Pragma("unroll") for (int n = 0; n < 2; ++n) _Pragma("unroll") for (int k = 0; k < 2; ++k) \
        acc[ai][bj][m][n] = __builtin_amdgcn_mfma_f32_16x16x32_bf16(Bt[n][k], At[m][k], acc[ai][bj][m][n], 0, 0, 0); __builtin_amdgcn_s_setprio(0); } while (0)
#define PG8_WAIT_V(n) asm volatile("s_waitcnt vmcnt(" #n ")" ::: "memory")
#define PG8_WAIT_L(n) asm volatile("s_waitcnt lgkmcnt(" #n ")" ::: "memory")
#define PG8_BAR __builtin_amdgcn_s_barrier()
#define PG8_SCHED __builtin_amdgcn_sched_barrier(0)
    Unit cur, nxt; int ui = 0;
    if (!S.next(0, cur)) return;
    f32x4 acc[2][2][4][2];
#pragma unroll
    for (int a = 0; a < 2; ++a)
#pragma unroll
        for (int b = 0; b < 2; ++b)
#pragma unroll
            for (int m = 0; m < 4; ++m)
#pragma unroll
                for (int n = 0; n < 2; ++n) acc[a][b][m][n] = (f32x4){0.f, 0.f, 0.f, 0.f};
    bf16x8 At[4][2], B0[2][2], B1[2][2];
    const char* cA = (const char*)g.A + (size_t)cur.pm * tstep; const char* cB = (const char*)g.Bt + (size_t)cur.pn * tstep;
    S.a_ready(cur);
    if constexpr (SP2) {
        PG8_STAGE(PG8_SB(0, 0), cB, voffB); PG8_STAGE(PG8_SB(0, 1), cB + hstep, voffB); PG8_STAGE(PG8_SA(0, 0), cA, voffA); PG8_STAGE(PG8_SA(0, 1), cA + hstep, voffA);
        if (wr == 1) PG8_BAR;
        PG8_WAIT_V(2); PG8_BAR;
        PG8_STAGE(PG8_SB(1, 0), cB + kstep, voffB); PG8_STAGE(PG8_SA(1, 0), cA + kstep, voffA); PG8_STAGE(PG8_SB(1, 1), cB + hstep + kstep, voffB);
        PG8_WAIT_V(6); PG8_BAR;
    } else {
        PG8_STAGE(PG8_SB(0, 0), cB, voffB); PG8_STAGE(PG8_SA(0, 0), cA, voffA); PG8_STAGE(PG8_SB(0, 1), cB + hstep, voffB); PG8_STAGE(PG8_SA(0, 1), cA + hstep, voffA);
        if (wr == 1) PG8_BAR;
        PG8_WAIT_V(4); PG8_BAR;
        PG8_STAGE(PG8_SB(1, 0), cB + kstep, voffB); PG8_STAGE(PG8_SA(1, 0), cA + kstep, voffA); PG8_STAGE(PG8_SB(1, 1), cB + hstep + kstep, voffB);
        PG8_WAIT_V(6); PG8_BAR;
    }
    for (;;) {
        const bool has_next = S.next(ui + 1, nxt);
        const char* nA = has_next ? (const char*)g.A + (size_t)nxt.pm * tstep : cA; const char* nB = has_next ? (const char*)g.Bt + (size_t)nxt.pn * tstep : cB;
        for (int t = 0; t < nt; t += 2) {
            const bool last = (t == nt - 2);
            const char* a1 = cA + (size_t)(t + 1) * kstep;
            const char* a2 = last ? nA : cA + (size_t)(t + 2) * kstep; const char* b2 = last ? nB : cB + (size_t)(t + 2) * kstep;
            const char* a3 = a2 + kstep; const char* b3 = b2 + kstep;
            if (last && has_next) S.a_ready(nxt);
            if constexpr (Epi::MID) { if (t == Epi::MID_T) E.mid(acc, cur, wr, wc, fr, fq); }
            if constexpr (SP2) {
            PG8_LDB(B0, 0, 0); PG8_LDB(B1, 0, 1); PG8_SCHED; PG8_LDA(At, 0, 0); PG8_STAGE(PG8_SA(1, 1), a1 + hstep, voffA);
            PG8_WAIT_V(8); PG8_WAIT_L(0); PG8_BAR; PG8_MMA(0, 0, At, B0); PG8_MMA(0, 1, At, B1); PG8_BAR; PG8_SCHED;
            PG8_LDA(At, 0, 1); PG8_STAGE(PG8_SB(0, 0), b2, voffB); PG8_STAGE(PG8_SB(0, 1), b2 + hstep, voffB); PG8_STAGE(PG8_SA(0, 0), a2, voffA);
            PG8_WAIT_V(8); PG8_WAIT_L(0); PG8_BAR; PG8_MMA(1, 0, At, B0); PG8_MMA(1, 1, At, B1); PG8_BAR; PG8_SCHED;
            PG8_LDB(B0, 1, 0); PG8_LDB(B1, 1, 1); PG8_SCHED; PG8_LDA(At, 1, 0); PG8_STAGE(PG8_SA(0, 1), a2 + hstep, voffA);
            PG8_WAIT_V(8); PG8_WAIT_L(0); PG8_BAR; PG8_MMA(0, 0, At, B0); PG8_MMA(0, 1, At, B1); PG8_BAR; PG8_SCHED;
            PG8_LDA(At, 1, 1); PG8_STAGE(PG8_SB(1, 0), b3, voffB); PG8_STAGE(PG8_SB(1, 1), b3 + hstep, voffB); PG8_STAGE(PG8_SA(1, 0), a3, voffA);
            PG8_WAIT_V(8); PG8_WAIT_L(0); PG8_BAR; PG8_MMA(1, 0, At, B0); PG8_MMA(1, 1, At, B1); PG8_BAR; PG8_SCHED;
            } else {
            PG8_LDB(B0, 0, 0); PG8_SCHED; PG8_LDA(At, 0, 0); PG8_STAGE(PG8_SA(1, 1), a1 + hstep, voffA);
            PG8_WAIT_L(8); PG8_BAR; PG8_WAIT_L(0); PG8_MMA(0, 0, At, B0); PG8_BAR; PG8_SCHED;
            PG8_LDB(B1, 0, 1); PG8_STAGE(PG8_SB(0, 0), b2, voffB);
            PG8_BAR; PG8_WAIT_L(0); PG8_MMA(0, 1, At, B1); PG8_BAR;
            PG8_LDA(At, 0, 1); PG8_STAGE(PG8_SA(0, 0), a2, voffA);
            PG8_BAR; PG8_WAIT_L(0); PG8_MMA(1, 0, At, B0); PG8_BAR; PG8_SCHED;
            PG8_STAGE(PG8_SB(0, 1), b2 + hstep, voffB);
            PG8_WAIT_V(6); PG8_BAR; PG8_MMA(1, 1, At, B1); PG8_BAR;
            PG8_LDB(B0, 1, 0); PG8_SCHED; PG8_LDA(At, 1, 0); PG8_STAGE(PG8_SA(0, 1), a2 + hstep, voffA);
            PG8_WAIT_L(8); PG8_BAR; PG8_WAIT_L(0); PG8_MMA(0, 0, At, B0); PG8_BAR; PG8_SCHED;
            PG8_LDB(B1, 1, 1); PG8_STAGE(PG8_SB(1, 0), b3, voffB);
            PG8_BAR; PG8_WAIT_L(0); PG8_MMA(0, 1, At, B1); PG8_BAR;
            PG8_LDA(At, 1, 1); PG8_STAGE(PG8_SA(1, 0), a3, voffA);
            PG8_BAR; PG8_WAIT_L(0); PG8_MMA(1, 0, At, B0); PG8_BAR; PG8_SCHED;
            PG8_STAGE(PG8_SB(1, 1), b3 + hstep, voffB);
            PG8_WAIT_V(6); PG8_BAR; PG8_MMA(1, 1, At, B1); PG8_BAR;
            }
        }
        if constexpr (ALIGN_EPI) { if (wr == 0) PG8_BAR; }
        if constexpr (!Epi::AFTER_DRAIN) { E(acc, cur, wr, wc, fr, fq); S.done(cur); }
        if (!has_next) break;
#pragma unroll
        for (int a = 0; a < 2; ++a)
#pragma unroll
            for (int b = 0; b < 2; ++b)
#pragma unroll
                for (int m = 0; m < 4; ++m)
#pragma unroll
                    for (int n = 0; n < 2; ++n) acc[a][b][m][n] = (f32x4){0.f, 0.f, 0.f, 0.f};
        cur = nxt; cA = nA; cB = nB; ++ui;
        if constexpr (ALIGN_EPI) { if (wr == 1) PG8_BAR; }
    }
    PG8_WAIT_V(0);
    if constexpr (!ALIGN_EPI) { if (wr == 0) PG8_BAR; }
    PG8_BAR;
    if constexpr (Epi::AFTER_DRAIN) { E.fused(acc, cur, wr, wc, fr, fq, lds, wid, lane); S.done(cur); }
#undef PG8_SA
#undef PG8_SB
#undef PG8_STAGE
#undef PG8_LDA
#undef PG8_LDB
#undef PG8_MMA
#undef PG8_WAIT_V
#undef PG8_WAIT_L
#undef PG8_BAR
#undef PG8_SCHED
}
}

constexpr int NWAVES = 8;
constexpr int BATCH = 8, SEQ = 4096, D = 1024, DEPTH = 2, M = BATCH * SEQ, IN_COLS = 2304, FF = 2816, GU = 2 * FF;
constexpr float EPS = 1e-6f, LOG2E = 1.4426950408889634f, C2 = 0.125f * LOG2E;
constexpr int NPHASE = 12;
#ifndef TS_SCALE
#define TS_SCALE 0.01f
#endif
#ifndef GU_ALIGN
#define GU_ALIGN true
#endif
#ifndef GU_SP2
#define GU_SP2 true
#endif
#ifndef MK_DUP
#define MK_DUP -1
#endif
#ifndef MK_ONE_LAUNCH
#define MK_ONE_LAUNCH 0
#endif
constexpr size_t MiB = 1u << 20;
constexpr size_t WS_CTL = 0, CTL_ZERO_BYTES = 1 * MiB;
constexpr size_t WS_SS_MIX = 2 * MiB, WS_SSY = 4 * MiB, WS_SS_FFN = 6 * MiB;
constexpr size_t WS_RS = 1 * MiB;
constexpr size_t WS_W = 8 * MiB, W_LAYER = 23 * MiB, W_IN = 0, W_OUT = 9 * MiB / 2, W_GU = 13 * MiB / 2, W_DOWN = 35 * MiB / 2;
constexpr size_t WS_ATT = 368 * MiB;
constexpr size_t WS_XB = 96 * MiB, WS_PROJ = 160 * MiB, WS_Y = 304 * MiB, WS_ACT = 160 * MiB, WS_END = 440 * MiB;
constexpr int CW_BAR = 4096;
constexpr int RING_OFF = 0, RING_BYTES = 131072;
constexpr int LDSCTL_OFF = RING_BYTES, MISC_OFF = LDSCTL_OFF + 320;
constexpr int LDS_BYTES = 147456;
constexpr int TAB_OFF = LDSCTL_OFF + 512, TAB_UNITS = (LDS_BYTES - TAB_OFF) / 1024;
static_assert(TAB_UNITS >= 11 && TAB_OFF % 16 == 0, "row-scale tables: 11 units per workgroup in the gate/up phase on a 256-workgroup grid");
#define GAS __attribute__((address_space(1)))
#define LAS __attribute__((address_space(3)))
typedef unsigned short bf16;
typedef unsigned v4u __attribute__((ext_vector_type(4)));
typedef float f32x4 __attribute__((ext_vector_type(4)));
typedef short bf16x8 __attribute__((ext_vector_type(8)));
typedef GAS unsigned gu32;
typedef GAS unsigned long long gu64;
#define RLX_AGENT __ATOMIC_RELAXED, __HIP_MEMORY_SCOPE_AGENT
#define LDS_WAIT() asm volatile("s_waitcnt lgkmcnt(0)" ::: "memory")
#define VM_WAIT() asm volatile("s_waitcnt vmcnt(0)" ::: "memory")
__device__ __forceinline__ unsigned long long rt() { return __builtin_amdgcn_s_memrealtime(); }
__device__ __forceinline__ unsigned f2bf(float f) { unsigned u = __builtin_bit_cast(unsigned, f); return (u + 0x7fffu + ((u >> 16) & 1u)) >> 16; }
__device__ __forceinline__ unsigned pk2(float lo, float hi) { return f2bf(lo) | (f2bf(hi) << 16); }

#define XB_TMO      128
#define XB_XCNT(j)  (256  + 64 * (j))
#define XB_XSUB(j)  (1280 + 64 * (j))
#define XB_XGEN(j)  (2304 + 64 * (j))
#define XB_TOP      3328
#define XB_TOPGEN   3392
#define XCD_BAR_WORDS 3456
#define XB_SPIN_CAP (1u << 18)

__device__ __forceinline__ unsigned xb_ld(unsigned* p)              { return __hip_atomic_load(p, __ATOMIC_RELAXED, __HIP_MEMORY_SCOPE_AGENT); }
__device__ __forceinline__ unsigned xb_add(unsigned* p, unsigned v) { return __hip_atomic_fetch_add(p, v, __ATOMIC_RELAXED, __HIP_MEMORY_SCOPE_AGENT); }
__device__ __forceinline__ unsigned xb_xcc_id() { return (unsigned)__builtin_amdgcn_s_getreg((3 << 11) | 20) & 0xFu; }
#define XB_SPIN(cond, bar) do { unsigned _sp = 0; while (cond) { __builtin_amdgcn_s_sleep(1); \
    if ((++_sp & 255u) == 0u) { if (xb_ld(&(bar)[XB_TMO])) break; if (_sp > XB_SPIN_CAP) { atomicAdd(&(bar)[XB_TMO], 1u); break; } } } } while (0)

struct XcdBarrier {
    unsigned* bar; unsigned x;
    volatile LAS unsigned* st;
};

__device__ __forceinline__ XcdBarrier xcd_barrier_post(unsigned* bar, volatile LAS unsigned* st) {
    XcdBarrier b; b.bar = bar; b.x = xb_xcc_id(); b.st = st;
    if (threadIdx.x == 0) (void)xb_add(&bar[XB_XCNT(b.x)], 1u);
    return b;
}
__device__ __forceinline__ void xcd_barrier_complete(unsigned* bar, unsigned x, unsigned& nloc, unsigned& nx) {
    const unsigned G = gridDim.x * gridDim.y * gridDim.z;
    unsigned sum, cnt, mine, sp = 0u;
    for (;;) {
        sum = 0u; cnt = 0u; mine = 0u;
#pragma unroll
        for (unsigned j = 0; j < 16; ++j) { const unsigned c = xb_ld(&bar[XB_XCNT(j)]); sum += c; cnt += (c > 0u) ? 1u : 0u; mine = (j == x) ? c : mine; }
        if (sum == G) break;
        __builtin_amdgcn_s_sleep(1);
        if ((++sp & 255u) == 0u) { if (xb_ld(&bar[XB_TMO])) break; if (sp > XB_SPIN_CAP) { atomicAdd(&bar[XB_TMO], 1u); break; } }
    }
    nloc = mine > 0u ? mine : 1u; nx = cnt > 0u ? cnt : 1u;
}

__device__ __forceinline__ void xcd_barrier(const XcdBarrier& b) {
    asm volatile("s_waitcnt vmcnt(0)" ::: "memory");
    __syncthreads();
    if (threadIdx.x == 0) {
        unsigned* bar = b.bar;
        __builtin_amdgcn_s_waitcnt(0);
        unsigned nloc = b.st[0], nx = b.st[1];
        if (nloc == 0u) { xcd_barrier_complete(bar, b.x, nloc, nx); b.st[0] = nloc; b.st[1] = nx; }
        const unsigned old = xb_add(&bar[XB_XSUB(b.x)], 1u);
        const unsigned gen = old / nloc;
        if (old + 1u == (gen + 1u) * nloc) {
            __builtin_amdgcn_fence(__ATOMIC_RELEASE, "agent");
            asm volatile("s_waitcnt vmcnt(0)" ::: "memory");
            const unsigned og = xb_add(&bar[XB_TOP], 1u);
            const unsigned tg = og / nx;
            if (og + 1u == (tg + 1u) * nx) xb_add(&bar[XB_TOPGEN], 1u);
            else XB_SPIN(xb_ld(&bar[XB_TOPGEN]) == tg, bar);
            __builtin_amdgcn_fence(__ATOMIC_ACQUIRE, "agent");
            xb_add(&bar[XB_XGEN(b.x)], 1u);
            asm volatile("s_waitcnt vmcnt(0)" ::: "memory");
        } else {
            XB_SPIN(xb_ld(&bar[XB_XGEN(b.x)]) == gen, bar);
            __builtin_amdgcn_fence(__ATOMIC_ACQUIRE, "agent");
            asm volatile("s_waitcnt vmcnt(0)" ::: "memory");
        }
    }
    __syncthreads();
}

namespace att {
#ifndef TS_PROBE
#define TS_PROBE 0
#endif
#define TS_T0(k) unsigned long long ts0_ = 0; if ((TS_PROBE % 10) == (k) && tson) ts0_ = __builtin_amdgcn_s_memrealtime();
#define TS_T1(k) if ((TS_PROBE % 10) == (k) && tson) tsacc += (float)(__builtin_amdgcn_s_memrealtime() - ts0_);
#ifndef ATT_PROBE
#define ATT_PROBE 0
#endif
typedef short bf16x8 __attribute__((ext_vector_type(8)));
typedef short s16x4 __attribute__((ext_vector_type(4)));
typedef float f32x16 __attribute__((ext_vector_type(16)));
typedef float f32x4 __attribute__((ext_vector_type(4)));
typedef unsigned u32x4 __attribute__((ext_vector_type(4)));
typedef unsigned u32x2 __attribute__((ext_vector_type(2)));
typedef float f32x2_t __attribute__((ext_vector_type(2))); typedef __bf16 bf16x2_t __attribute__((ext_vector_type(2)));
typedef short v4i16_t __attribute__((ext_vector_type(4)));
#define ATT_LAS __attribute__((address_space(3)))
constexpr int SPAN = 1024, ST_BYTES = SPAN * 64 * 4 + SPAN * 8;
constexpr int LD = 2304, SEQL = 4096;
__device__ __forceinline__ unsigned cvtpk(float lo, float hi) { f32x2_t v = {lo, hi}; bf16x2_t b = __builtin_convertvector(v, bf16x2_t); return __builtin_bit_cast(unsigned, b); }
__device__ __forceinline__ s16x4 vtr(const ATT_LAS unsigned char* p) { return __builtin_bit_cast(s16x4, __builtin_amdgcn_ds_read_tr16_b64_v4i16((ATT_LAS v4i16_t*)p)); }
__device__ __forceinline__ void glds16(const void* gsrc, unsigned lds_dst) { unsigned keep;
#if ATT_PROBE == 5
    asm volatile("s_mov_b32 %0, m0\n\ts_mov_b32 m0, %2\n\ts_nop 0\n\tglobal_load_lds_dwordx4 %1, off\n\ts_mov_b32 m0, %0" : "=&s"(keep) : "v"(gsrc), "s"(lds_dst) : "memory");
#endif
    asm volatile("s_mov_b32 %0, m0\n\ts_mov_b32 m0, %2\n\ts_nop 0\n\tglobal_load_lds_dwordx4 %1, off\n\ts_mov_b32 m0, %0" : "=&s"(keep) : "v"(gsrc), "s"(lds_dst) : "memory"); }
#if ATT_PROBE == 5
#define ATT_WAITV(N) asm volatile("s_waitcnt vmcnt(%0)" :: "i"(2 * (N)) : "memory")
#else
#define ATT_WAITV(N) asm volatile("s_waitcnt vmcnt(" #N ")" ::: "memory")
#endif
#define ATT_WAITL() asm volatile("s_waitcnt lgkmcnt(0)" ::: "memory")

template <int K> __device__ __forceinline__ float a_addk(float a) { float r; asm("v_add_f32_e32 %0, %1, %2" : "=v"(r) : "i"(__builtin_bit_cast(int, (float)K)), "v"(a)); return r; }
__device__ __forceinline__ float a_add(float a, float b) { float r; asm("v_add_f32_e32 %0, %1, %2" : "=v"(r) : "v"(a), "v"(b)); return r; }
__device__ __forceinline__ float a_sub(float a, float b) { float r; asm("v_sub_f32_e32 %0, %1, %2" : "=v"(r) : "v"(a), "v"(b)); return r; }
__device__ __forceinline__ float a_fma_nabs(float sl, float x, float c) { float r; asm("v_fma_f32 %0, -%1, |%2|, %3" : "=v"(r) : "v"(sl), "v"(x), "v"(c)); return r; }
__device__ __forceinline__ float swap32max(float v) { auto rr = __builtin_amdgcn_permlane32_swap(__float_as_uint(v), __float_as_uint(v), false, false); return __builtin_fmaxf(__uint_as_float(rr[0]), __uint_as_float(rr[1])); }
constexpr float THR = 8.0f;

template <int SIDE, bool EDGE, int R> __device__ __forceinline__ void bias1(float (&s)[16], const f32x16& S, float c0, float slope2) {
    if constexpr (R < 16) { const float t = a_addk<(R & 3) + 8 * (R >> 2)>(c0); const float v = a_fma_nabs(slope2, t, S[R]);
        if constexpr (EDGE) s[R] = (__builtin_fabsf(t) > (float)SIDE) ? -1e30f : v; else s[R] = v;
        bias1<SIDE, EDGE, R + 1>(s, S, c0, slope2); }
}
template <int SIDE>
__device__ __forceinline__ void softmax_step(f32x16& S, float c0, float slope2, bool edge, bool fresh, float& m, float& l, f32x16& o0, f32x16& o1, bool& mz, bf16x8& pk0, bf16x8& pk1) {
    asm volatile("s_nop 15\n\ts_nop 7" : "+v"(S));
    float s[16];
    if (edge) bias1<SIDE, true, 0>(s, S, c0, slope2); else bias1<SIDE, false, 0>(s, S, c0, slope2);
    if (!mz) {
#pragma unroll
        for (int r = 0; r < 16; ++r) s[r] = a_sub(s[r], m);
    }
    float ra = __builtin_fmaxf(__builtin_fmaxf(s[0], s[1]), s[2]), rb = __builtin_fmaxf(__builtin_fmaxf(s[3], s[4]), s[5]);
    ra = __builtin_fmaxf(__builtin_fmaxf(ra, s[6]), s[7]); rb = __builtin_fmaxf(__builtin_fmaxf(rb, s[8]), s[9]);
    ra = __builtin_fmaxf(__builtin_fmaxf(ra, s[10]), s[11]); rb = __builtin_fmaxf(__builtin_fmaxf(rb, s[12]), s[13]);
    ra = __builtin_fmaxf(__builtin_fmaxf(ra, s[14]), s[15]);
    const float rm = swap32max(__builtin_fmaxf(ra, rb));
    const bool need = fresh ? __any(rm > THR || rm < -64.0f) : __any(rm > THR);
    if (need) {
        const float dl = fresh ? rm : __builtin_fmaxf(rm, 0.f);
        m += dl; mz = false;
#pragma unroll
        for (int r = 0; r < 16; ++r) s[r] -= dl;
        if (!fresh) { const float f = __builtin_amdgcn_exp2f(-dl); l *= f; o0 = o0 * f; o1 = o1 * f; }
    }
#pragma unroll
    for (int r = 0; r < 16; ++r) s[r] = __builtin_amdgcn_exp2f(s[r]);
    asm volatile("s_nop 1" : "+v"(s[0]), "+v"(s[1]), "+v"(s[2]), "+v"(s[3]), "+v"(s[4]), "+v"(s[5]), "+v"(s[6]), "+v"(s[7]), "+v"(s[8]), "+v"(s[9]), "+v"(s[10]), "+v"(s[11]), "+v"(s[12]), "+v"(s[13]), "+v"(s[14]), "+v"(s[15]));
    float p0 = a_add(s[0], s[1]), p1 = a_add(s[2], s[3]);
#pragma unroll
    for (int r = 4; r < 16; r += 2) { p0 = a_add(p0, s[r]); p1 = a_add(p1, s[r + 1]); }
    l += a_add(p0, p1);
    u32x4 w0, w1;
    w0[0] = cvtpk(s[0], s[1]); w0[1] = cvtpk(s[2], s[3]); w0[2] = cvtpk(s[4], s[5]); w0[3] = cvtpk(s[6], s[7]);
    w1[0] = cvtpk(s[8], s[9]); w1[1] = cvtpk(s[10], s[11]); w1[2] = cvtpk(s[12], s[13]); w1[3] = cvtpk(s[14], s[15]);
    pk0 = __builtin_bit_cast(bf16x8, w0); pk1 = __builtin_bit_cast(bf16x8, w1);
}

struct QState { float m, l; f32x16 o0, o1; bool mz, fresh; };

template <int SIDE>
__device__ __forceinline__ void pair(const unsigned short* pb, int tqA, int dil, int qoff, int koff, int voff, float slope2, QState& A, QState& B, unsigned ldsw, const ATT_LAS unsigned char* ldsp, int lane, float& tsacc, bool tson) {
    constexpr int NT = (2 * SIDE + 32) / 32;
    TS_T0(2)
    const int u = lane & 31, hi = lane >> 5;
    int tlo = 0, thi = NT;
    while (tqA + dil * (32 * tlo - SIDE) < 0) ++tlo;
    while (tqA + dil * (32 * thi - SIDE) >= SEQL) --thi;
    const int r8 = lane >> 3;
    const unsigned short* kbase = pb + (size_t)(tqA + dil * (r8 - SIDE)) * LD + koff + 8 * ((lane & 7) ^ (r8 >> 1));
    const unsigned short* vbase = pb + (size_t)(tqA + dil * (r8 - SIDE)) * LD + voff + 8 * ((lane & 7) ^ (4 * ((r8 >> 1) & 1)));
    const int kx = 8 * ((((lane & 7) ^ (r8 >> 1)) ^ 4) - ((lane & 7) ^ (r8 >> 1)));
    const size_t rstep = (size_t)dil * LD;
#define ATT_DMA_K(t, slot) do { const unsigned short* p_ = kbase + (size_t)(32 * (t)) * rstep; const unsigned d_ = ldsw + (slot) * 8192u; \
        glds16(p_, d_); glds16(p_ + 8 * rstep + kx, d_ + 1024u); glds16(p_ + 16 * rstep, d_ + 2048u); glds16(p_ + 24 * rstep + kx, d_ + 3072u); } while (0)
#define ATT_DMA_V(t, slot) do { const unsigned short* p_ = vbase + (size_t)(32 * (t)) * rstep; const unsigned d_ = ldsw + (slot) * 8192u + 4096u; \
        glds16(p_, d_); glds16(p_ + 8 * rstep, d_ + 1024u); glds16(p_ + 16 * rstep, d_ + 2048u); glds16(p_ + 24 * rstep, d_ + 3072u); } while (0)
    ATT_DMA_K(tlo, tlo & 1); ATT_DMA_V(tlo, tlo & 1);
    if (tlo + 1 <= thi) { ATT_DMA_K(tlo + 1, (tlo + 1) & 1); ATT_DMA_V(tlo + 1, (tlo + 1) & 1); }
    bf16x8 qa[4], qb[4];
    { const unsigned short* qp = pb + (size_t)(tqA + u * dil) * LD + qoff + 8 * hi;
#pragma unroll
      for (int d0 = 0; d0 < 4; ++d0) { qa[d0] = *(const bf16x8*)(qp + 16 * d0); qb[d0] = *(const bf16x8*)(qp + (size_t)32 * rstep + 16 * d0); } }
    asm volatile("" : "+v"(qa[0]), "+v"(qa[1]), "+v"(qa[2]), "+v"(qa[3]), "+v"(qb[0]), "+v"(qb[1]), "+v"(qb[2]), "+v"(qb[3]));
    asm volatile("" : "+v"(A.o0), "+v"(A.o1), "+v"(B.o0), "+v"(B.o1), "+v"(A.m), "+v"(A.l), "+v"(B.m), "+v"(B.l));
    TS_T1(2)
    const int sw = (u >> 1) & 7;
    const int ka0 = u * 128 + (((0 + hi) ^ sw) << 4), ka1 = u * 128 + (((2 + hi) ^ sw) << 4), ka2 = u * 128 + (((4 + hi) ^ sw) << 4), ka3 = u * 128 + (((6 + hi) ^ sw) << 4);
    const int q_ = (lane & 15) >> 2, p_ = lane & 3, g16 = (lane >> 4) & 1;
    const int vb0 = 4096 + (4 * hi + q_) * 128 + ((4 * (q_ >> 1) + 2 * g16 + (p_ >> 1)) << 4) + 8 * (p_ & 1), vb1 = vb0 ^ 64;
    { TS_T0(3)
#pragma unroll 1
    for (int t = tlo; t <= thi; ++t) {
        const ATT_LAS unsigned char* sl = ldsp + (t & 1) * 8192;
        { TS_T0(5) if (t + 1 <= thi) ATT_WAITV(12); else ATT_WAITV(4);
        TS_T1(5) }
        bf16x8 kf[4];
        kf[0] = *(const ATT_LAS bf16x8*)(sl + ka0); kf[1] = *(const ATT_LAS bf16x8*)(sl + ka1); kf[2] = *(const ATT_LAS bf16x8*)(sl + ka2); kf[3] = *(const ATT_LAS bf16x8*)(sl + ka3);
        asm volatile("s_waitcnt lgkmcnt(0)" : "+v"(kf[0]), "+v"(kf[1]), "+v"(kf[2]), "+v"(kf[3]) :: "memory");
        if (t + 2 <= thi) ATT_DMA_K(t + 2, t & 1);
        const float c0 = (float)(32 * t - SIDE + 4 * hi - u);
        bf16x8 pa0, pa1, pb0, pb1;
        const bool actA = t <= NT - 1, actB = t >= 1;
        if (actA) {
            f32x16 S;
#pragma unroll
            for (int r = 0; r < 16; ++r) S[r] = 0.f;
#pragma unroll
            for (int d0 = 0; d0 < 4; ++d0) S = __builtin_amdgcn_mfma_f32_32x32x16_bf16(kf[d0], qa[d0], S, 0, 0, 0);
            softmax_step<SIDE>(S, c0, slope2, t == 0 || t == NT - 1, A.fresh, A.m, A.l, A.o0, A.o1, A.mz, pa0, pa1); A.fresh = false;
        }
        if (actB) {
            f32x16 S;
#pragma unroll
            for (int r = 0; r < 16; ++r) S[r] = 0.f;
#pragma unroll
            for (int d0 = 0; d0 < 4; ++d0) S = __builtin_amdgcn_mfma_f32_32x32x16_bf16(kf[d0], qb[d0], S, 0, 0, 0);
            softmax_step<SIDE>(S, c0 - 32.0f, slope2, t == 1 || t == NT, B.fresh, B.m, B.l, B.o0, B.o1, B.mz, pb0, pb1); B.fresh = false;
        }
        { TS_T0(5) if (t + 2 <= thi) ATT_WAITV(12); else if (t + 1 <= thi) ATT_WAITV(8); else ATT_WAITV(0);
        TS_T1(5) }
        {
            const s16x4 a0 = vtr(sl + vb0), a1 = vtr(sl + vb0 + 1024), b0 = vtr(sl + vb0 + 2048), b1 = vtr(sl + vb0 + 3072);
            bf16x8 v00 = __builtin_shufflevector(a0, a1, 0, 1, 2, 3, 4, 5, 6, 7), v01 = __builtin_shufflevector(b0, b1, 0, 1, 2, 3, 4, 5, 6, 7);
            if (actA) { A.o0 = __builtin_amdgcn_mfma_f32_32x32x16_bf16(v00, pa0, A.o0, 0, 0, 0); A.o0 = __builtin_amdgcn_mfma_f32_32x32x16_bf16(v01, pa1, A.o0, 0, 0, 0); }
            if (actB) { B.o0 = __builtin_amdgcn_mfma_f32_32x32x16_bf16(v00, pb0, B.o0, 0, 0, 0); B.o0 = __builtin_amdgcn_mfma_f32_32x32x16_bf16(v01, pb1, B.o0, 0, 0, 0); }
        }
        {
            const s16x4 c0_ = vtr(sl + vb1), c1 = vtr(sl + vb1 + 1024), d0_ = vtr(sl + vb1 + 2048), d1 = vtr(sl + vb1 + 3072);
            bf16x8 v10 = __builtin_shufflevector(c0_, c1, 0, 1, 2, 3, 4, 5, 6, 7), v11 = __builtin_shufflevector(d0_, d1, 0, 1, 2, 3, 4, 5, 6, 7);
            asm volatile("s_waitcnt lgkmcnt(0)" : "+v"(v10), "+v"(v11) :: "memory");
            if (t + 2 <= thi) ATT_DMA_V(t + 2, t & 1);
            if (actA) { A.o1 = __builtin_amdgcn_mfma_f32_32x32x16_bf16(v10, pa0, A.o1, 0, 0, 0); A.o1 = __builtin_amdgcn_mfma_f32_32x32x16_bf16(v11, pa1, A.o1, 0, 0, 0); }
            if (actB) { B.o1 = __builtin_amdgcn_mfma_f32_32x32x16_bf16(v10, pb0, B.o1, 0, 0, 0); B.o1 = __builtin_amdgcn_mfma_f32_32x32x16_bf16(v11, pb1, B.o1, 0, 0, 0); }
        }
    }
    TS_T1(3) }
#undef ATT_DMA_K
#undef ATT_DMA_V
}
__device__ __forceinline__ void finish(const QState& Q, unsigned short* yrow, float* ssyp, int hi) {
    const float lt = Q.l + __shfl_xor(Q.l, 32), inv = 1.0f / lt; float sq = 0.f;
#pragma unroll
    for (int g = 0; g < 4; ++g) {
        const float a0 = Q.o0[4 * g] * inv, a1 = Q.o0[4 * g + 1] * inv, a2 = Q.o0[4 * g + 2] * inv, a3 = Q.o0[4 * g + 3] * inv;
        const float b0 = Q.o1[4 * g] * inv, b1 = Q.o1[4 * g + 1] * inv, b2 = Q.o1[4 * g + 2] * inv, b3 = Q.o1[4 * g + 3] * inv;
        sq += ((a0 * a0 + a1 * a1) + (a2 * a2 + a3 * a3)) + ((b0 * b0 + b1 * b1) + (b2 * b2 + b3 * b3));
        u32x2 wa, wb; wa[0] = cvtpk(a0, a1); wa[1] = cvtpk(a2, a3); wb[0] = cvtpk(b0, b1); wb[1] = cvtpk(b2, b3);
        *(u32x2*)(yrow + 8 * g + 4 * hi) = wa; *(u32x2*)(yrow + 32 + 8 * g + 4 * hi) = wb;
    }
    sq += __shfl_xor(sq, 32);
    if (hi == 0) *ssyp = sq;
}
__device__ __forceinline__ void st_load(QState& Q, const float* stO, const float* stML, int ts, int hi) {
    const f32x2_t ml = *(const f32x2_t*)(stML + 2 * ts); Q.m = ml[0]; Q.l = hi == 0 ? ml[1] : 0.f; Q.mz = !__any(ml[0] != 0.f); Q.fresh = false;
#pragma unroll
    for (int g = 0; g < 4; ++g) { const f32x4 a = *(const f32x4*)(stO + ts * 64 + 8 * g + 4 * hi), c = *(const f32x4*)(stO + ts * 64 + 32 + 8 * g + 4 * hi);
        Q.o0[4 * g] = a[0]; Q.o0[4 * g + 1] = a[1]; Q.o0[4 * g + 2] = a[2]; Q.o0[4 * g + 3] = a[3]; Q.o1[4 * g] = c[0]; Q.o1[4 * g + 1] = c[1]; Q.o1[4 * g + 2] = c[2]; Q.o1[4 * g + 3] = c[3]; }
}
__device__ __forceinline__ void st_save(const QState& Q, float* stO, float* stML, int ts, int hi) {
    const float lt = Q.l + __shfl_xor(Q.l, 32);
    if (hi == 0) { f32x2_t ml; ml[0] = Q.m; ml[1] = lt; *(f32x2_t*)(stML + 2 * ts) = ml; }
#pragma unroll
    for (int g = 0; g < 4; ++g) { f32x4 a, c; a[0] = Q.o0[4 * g]; a[1] = Q.o0[4 * g + 1]; a[2] = Q.o0[4 * g + 2]; a[3] = Q.o0[4 * g + 3]; c[0] = Q.o1[4 * g]; c[1] = Q.o1[4 * g + 1]; c[2] = Q.o1[4 * g + 2]; c[3] = Q.o1[4 * g + 3];
        *(f32x4*)(stO + ts * 64 + 8 * g + 4 * hi) = a; *(f32x4*)(stO + ts * 64 + 32 + 8 * g + 4 * hi) = c; }
}
__device__ __forceinline__ void st_init(QState& Q, float l, bool fresh) { Q.m = 0.f; Q.l = l; Q.mz = true; Q.fresh = fresh;
#pragma unroll
    for (int r = 0; r < 16; ++r) { Q.o0[r] = 0.f; Q.o1[r] = 0.f; } }
__device__ __forceinline__ void phase(const unsigned short* proj, const float* sink, unsigned short* Y, float* SSY, unsigned char* state_ws, ATT_LAS unsigned char* lds, int vcu, int G, float* tsw) {
    constexpr int NB = 8, NITEM = 2 * NB * 8 * (SEQL / SPAN);
    int tid_ = threadIdx.x; asm volatile("" : "+v"(tid_));
    const int lane = tid_ & 63, wave = __builtin_amdgcn_readfirstlane(tid_ >> 6), u = lane & 31, hi = lane >> 5;
    const ATT_LAS unsigned char* ldsp = lds + wave * 16384;
    const unsigned ldsw = (unsigned)__builtin_amdgcn_readfirstlane((int)(unsigned)(uintptr_t)ldsp);
    float* stO = (float*)(state_ws + (size_t)blockIdx.x * ST_BYTES); float* stML = stO + SPAN * 64;
    float tsacc = 0.f; const bool tson0 = TS_PROBE != 0 && vcu == 1 && wave == 0;
    for (int it = vcu; it < NITEM; it += G)
    for (int rep_ = 0; rep_ < ((ATT_PROBE == 3 && it >= NITEM / 2) || (ATT_PROBE == 4 && it < NITEM / 2) ? 2 : 1); ++rep_) {
        const bool dg = it < NITEM / 2; const int id = dg ? it : it - NITEM / 2;
        const int span = id & 3, h = (id >> 2) & 7, b = id >> 5, tok0 = span * SPAN, h16 = dg ? h : 8 + h;
        const unsigned short* pb = proj + (size_t)b * SEQL * LD;
        const float slope = __builtin_amdgcn_exp2f(-0.5f * (float)((dg ? 8 + h : h) + 1)) * 1.4426950408889634f;
        if (dg) {
            const bool tson = tson0 && TS_PROBE < 10; TS_T0(1)
            const int qoff = h * 64, koff = 512 + h * 64, voff = 1024 + h * 64;
#pragma unroll 1
            for (int pass = 0; pass < 3; ++pass) {
                const int dil = pass == 0 ? 16 : (pass == 1 ? 4 : 1);
#pragma unroll 1
                for (int k = 0; k < 2; ++k) {
                    const int p = wave + 8 * k;
                    const int tqA = tok0 + (pass == 0 ? p : (pass == 1 ? 256 * (p >> 2) + (p & 3) : 64 * p));
                    const int tsA = tqA - tok0 + u * dil, tsB = tsA + 32 * dil;
                    QState A, B;
                    if (pass == 0) { st_init(A, 0.f, true); st_init(B, 0.f, true); }
                    else { TS_T0(6) st_load(A, stO, stML, tsA, hi); st_load(B, stO, stML, tsB, hi); asm volatile("" : "+v"(A.o0), "+v"(A.o1), "+v"(B.o0), "+v"(B.o1)); TS_T1(6) }
                    pair<64>(pb, tqA, dil, qoff, koff, voff, slope * (float)dil, A, B, ldsw, ldsp, lane, tsacc, tson && TS_PROBE < 10);
#if ATT_PROBE == 1
                    { QState A2 = A, B2 = B; pair<64>(pb, tqA, dil, qoff, koff, voff, slope * (float)dil, A2, B2, ldsw, ldsp, lane, tsacc, false);
                      float sm = A2.m + A2.l + B2.m + B2.l;
#pragma unroll
                      for (int r = 0; r < 16; ++r) sm += A2.o0[r] + A2.o1[r] + B2.o0[r] + B2.o1[r];
                      if (sm == 12345.678f) stML[0] = sm; }
#endif
#if ATT_PROBE == 2
                    if (pass < 2) { st_save(A, stO, stML, tsA, hi); st_save(B, stO, stML, tsB, hi); asm volatile("s_waitcnt vmcnt(0)" ::: "memory"); st_load(A, stO, stML, tsA, hi); st_load(B, stO, stML, tsB, hi); A.l = A.l + __shfl_xor(A.l, 32) * 0.f; }
#endif
                    if (pass < 2) { TS_T0(7) st_save(A, stO, stML, tsA, hi); st_save(B, stO, stML, tsB, hi); if (TS_PROBE == 7) asm volatile("s_waitcnt vmcnt(0)" ::: "memory"); TS_T1(7) }
                    else { TS_T0(4) const size_t tok = (size_t)b * SEQL + tqA + u; finish(A, Y + tok * 1024 + h16 * 64, SSY + tok * 16 + h16, hi); finish(B, Y + (tok + 32) * 1024 + h16 * 64, SSY + (tok + 32) * 16 + h16, hi); if (TS_PROBE == 4) asm volatile("s_waitcnt vmcnt(0)" ::: "memory"); TS_T1(4) }
                }
                { TS_T0(8) __syncthreads(); TS_T1(8) }
            }
            TS_T1(1)
        } else {
            const bool tson = tson0 && TS_PROBE >= 10; TS_T0(1)
            const int qoff = 1536 + h * 64, koff = 2048 + (h >> 2) * 64, voff = 2176 + (h >> 2) * 64;
            const float sk2 = sink[h] * 1.4426950408889634f;
#pragma unroll 1
            for (int k = 0; k < 2; ++k) {
                const int tqA = tok0 + 64 * (wave + 8 * k);
                const float lsink = hi == 0 ? __builtin_amdgcn_exp2f(sk2) : 0.f;
                QState A, B; st_init(A, lsink, false); st_init(B, lsink, false);
                pair<128>(pb, tqA, 1, qoff, koff, voff, slope, A, B, ldsw, ldsp, lane, tsacc, tson && TS_PROBE >= 10);
#if ATT_PROBE == 1
                { QState A2 = A, B2 = B; pair<128>(pb, tqA, 1, qoff, koff, voff, slope, A2, B2, ldsw, ldsp, lane, tsacc, false);
                  float sm = A2.m + A2.l + B2.m + B2.l;
#pragma unroll
                  for (int r = 0; r < 16; ++r) sm += A2.o0[r] + A2.o1[r] + B2.o0[r] + B2.o1[r];
                  if (sm == 12345.678f) stML[0] = sm; }
#endif
                { TS_T0(4) const size_t tok = (size_t)b * SEQL + tqA + u; finish(A, Y + tok * 1024 + h16 * 64, SSY + tok * 16 + h16, hi); finish(B, Y + (tok + 32) * 1024 + h16 * 64, SSY + (tok + 32) * 16 + h16, hi); if (TS_PROBE == 14) asm volatile("s_waitcnt vmcnt(0)" ::: "memory"); TS_T1(4) }
            }
            TS_T1(1)
        }
    }
    if (TS_PROBE != 0 && tson0 && lane == 0) atomicAdd(tsw, tsacc);
    __syncthreads();
}
#undef ATT_LAS
}

struct Frame {
    LAS unsigned char* lds;
    volatile LAS unsigned* MISC;
    gu32* ctl;
    int tid, lane, wave;
    int vcu, G;
};
__device__ __forceinline__ float wave_sum(float v) {
#pragma unroll
    for (int o = 1; o < 64; o <<= 1) v += __shfl_xor(v, o);
    return v;
}
__device__ __forceinline__ void p0_item(const float* W, int K, int N, bf16* WT, int out_row0, const float* gk, float nscale, LAS float* scr, int k0, int n0, int lane) {
    float wv[32];
#pragma unroll
    for (int i = 0; i < 32; ++i) wv[i] = W[(size_t)(k0 + 2 * i + (lane >> 5)) * N + n0 + (lane & 31)];
    float gv[32];
#pragma unroll
    for (int i = 0; i < 32; ++i) gv[i] = gk ? gk[k0 + 2 * i + (lane >> 5)] * nscale : nscale;
#pragma unroll
    for (int i = 0; i < 32; ++i) scr[(2 * i + (lane >> 5)) * 33 + (lane & 31)] = wv[i] * gv[i];
    LDS_WAIT(); asm volatile("" ::: "memory");
    const int c = lane & 7;
#pragma unroll
    for (int j = 0; j < 4; ++j) { const int n = (lane >> 3) + 8 * j; const LAS float* s = scr + (8 * c) * 33 + n;
        v4u o; o.x = pk2(s[0 * 33], s[1 * 33]); o.y = pk2(s[2 * 33], s[3 * 33]); o.z = pk2(s[4 * 33], s[5 * 33]); o.w = pk2(s[6 * 33], s[7 * 33]);
        *(GAS v4u*)(WT + (size_t)(out_row0 + n) * K + k0 + 8 * c) = o; }
    LDS_WAIT(); asm volatile("" ::: "memory");
}
struct Ptrs {
    const float *x, *g_mix, *w_in, *g_out_dil, *g_out_win, *sink, *w_out, *g_ffn, *w_gate, *w_up, *w_down, *g_final;
    float* out; unsigned char* ws;
};
__device__ __forceinline__ void p0_weights(const Ptrs& P, int L, LAS float* scr, int w, int nworkers, int lane) {
    constexpr int I_IN = (D / 64) * (IN_COLS / 32), I_OUT = (D / 64) * (D / 32), I_G = (D / 64) * (FF / 32), I_D = (FF / 64) * (D / 32);
    constexpr int I_LAYER = I_IN + I_OUT + 2 * I_G + I_D;
    bf16* wl = (bf16*)(P.ws + WS_W + (size_t)L * W_LAYER);
    for (int it = w; it < I_LAYER; it += nworkers) {
        int r = it;
        if (r < I_IN) { const int nblk = IN_COLS / 32, kb = r / nblk, nb = r % nblk, n0 = 32 * nb; const bool isq = (n0 < 512) || (n0 >= 1536 && n0 < 2048);
            p0_item(P.w_in + (size_t)L * D * IN_COLS, D, IN_COLS, (bf16*)((unsigned char*)wl + W_IN), n0, P.g_mix + L * D, isq ? C2 : 1.0f, scr, 64 * kb, n0, lane); continue; } r -= I_IN;
        if (r < I_OUT) { const int nblk = D / 32, kb = r / nblk, nb = r % nblk, n0 = 32 * nb, k0 = 64 * kb;
            const float* gk = (k0 < 512) ? (P.g_out_dil + L * 512) : (P.g_out_win + L * 512 - 512);
            p0_item(P.w_out + (size_t)L * D * D, D, D, (bf16*)((unsigned char*)wl + W_OUT), n0, gk, 1.0f, scr, k0, n0, lane); continue; } r -= I_OUT;
        if (r < 2 * I_G) { const bool up = r >= I_G; if (up) r -= I_G; const int nblk = FF / 32, kb = r / nblk, nb = r % nblk, n0 = 32 * nb;
            const int orow = 256 * (n0 / 128) + (up ? 128 : 0) + (n0 % 128);
            p0_item((up ? P.w_up : P.w_gate) + (size_t)L * D * FF, D, FF, (bf16*)((unsigned char*)wl + W_GU), orow, P.g_ffn + L * D, 1.0f, scr, 64 * kb, n0, lane); continue; } r -= 2 * I_G;
        { const int nblk = D / 32, kb = r / nblk, nb = r % nblk, n0 = 32 * nb;
            p0_item(P.w_down + (size_t)L * FF * D, FF, D, (bf16*)((unsigned char*)wl + W_DOWN), n0, nullptr, 1.0f, scr, 64 * kb, n0, lane); }
    }
}
__device__ __forceinline__ void p0_weights_in_tail(Frame& F0, const Ptrs& P, int L, int first_idle, int n_idle) {
    int t_ = threadIdx.x; asm volatile("" : "+v"(t_)); const int lane = t_ & 63, wave = __builtin_amdgcn_readfirstlane(t_ >> 6);
    LAS float* scr = (LAS float*)(F0.lds + RING_OFF + wave * 16384);
    p0_weights(P, L, scr, ((int)blockIdx.x - first_idle) * NWAVES + wave, n_idle * NWAVES, lane);
}
__device__ __forceinline__ void p0_prologue(Frame& F0, const Ptrs& P, bool all_layers) {
    Frame F = F0; { int t_ = threadIdx.x; asm volatile("" : "+v"(t_)); F.tid = t_; F.lane = t_ & 63; F.wave = __builtin_amdgcn_readfirstlane(t_ >> 6); }
    LAS float* scr = (LAS float*)(F.lds + RING_OFF + F.wave * 16384);
    const int gw = F.vcu * NWAVES + F.wave, NGW = F.G * NWAVES;
    for (int L = 0; L < (all_layers ? DEPTH : 1); ++L) p0_weights(P, L, scr, gw, NGW, F.lane);
    bf16* XB = (bf16*)(P.ws + WS_XB); float* ss = (float*)(P.ws + WS_SS_MIX);
    for (int m0 = gw; m0 < M; m0 += 4 * NGW) {
        f32x4 v[4][4];
#pragma unroll
        for (int r = 0; r < 4; ++r) { const int m = m0 + r * NGW; if (m < M) { const GAS f32x4* xr = (const GAS f32x4*)(P.x + (size_t)m * D) + F.lane;
#pragma unroll
            for (int j = 0; j < 4; ++j) v[r][j] = xr[64 * j]; } }
#pragma unroll
        for (int r = 0; r < 4; ++r) { const int m = m0 + r * NGW; if (m < M) { float s = 0.f;
#pragma unroll
            for (int j = 0; j < 4; ++j) s += (v[r][j].x * v[r][j].x + v[r][j].y * v[r][j].y) + (v[r][j].z * v[r][j].z + v[r][j].w * v[r][j].w);
            s = wave_sum(s);
            GAS unsigned long long* o8 = (GAS unsigned long long*)(XB + (size_t)m * D) + F.lane;
#pragma unroll
            for (int j = 0; j < 4; ++j) o8[64 * j] = (unsigned long long)pk2(v[r][j].x, v[r][j].y) | ((unsigned long long)pk2(v[r][j].z, v[r][j].w) << 32);
            if (F.lane < 16) ss[(size_t)m * 16 + F.lane] = (F.lane == 0) ? s : 0.f; } }
    }
}
__device__ __forceinline__ void final_norm(Frame& F0, const Ptrs& P) {
    Frame F = F0; { int t_ = threadIdx.x; asm volatile("" : "+v"(t_)); F.tid = t_; F.lane = t_ & 63; F.wave = __builtin_amdgcn_readfirstlane(t_ >> 6); }
    const int gw = F.vcu * NWAVES + F.wave, NGW = F.G * NWAVES; const float* ss = (const float*)(P.ws + WS_SS_MIX); const bf16* XB = (const bf16*)(P.ws + WS_XB);
    f32x4 g[4];
#pragma unroll
    for (int j = 0; j < 4; ++j) g[j] = ((const GAS f32x4*)P.g_final)[F.lane + 64 * j];
    for (int m0 = gw; m0 < M; m0 += 4 * NGW) {
        unsigned long long w[4][4]; float rsv[4];
#pragma unroll
        for (int r = 0; r < 4; ++r) { const int m = m0 + r * NGW; if (m < M) { const GAS unsigned long long* xr = (const GAS unsigned long long*)(XB + (size_t)m * D) + F.lane;
#pragma unroll
            for (int j = 0; j < 4; ++j) w[r][j] = xr[64 * j];
            rsv[r] = pg8::ss_row_sum(ss, m); } }
#pragma unroll
        for (int r = 0; r < 4; ++r) { const int m = m0 + r * NGW; if (m < M) { GAS f32x4* orow = (GAS f32x4*)(P.out + (size_t)m * D) + F.lane;
            const float rs = __builtin_amdgcn_rsqf(rsv[r] * (1.0f / 1024.0f) + EPS);
#pragma unroll
            for (int j = 0; j < 4; ++j) { const unsigned lo = (unsigned)w[r][j], hi = (unsigned)(w[r][j] >> 32);
                f32x4 v; v.x = __uint_as_float(lo << 16); v.y = __uint_as_float(lo & 0xffff0000u); v.z = __uint_as_float(hi << 16); v.w = __uint_as_float(hi & 0xffff0000u);
                orow[64 * j] = v * rs * g[j]; } } }
    }
#if defined(TS_PROBE) && TS_PROBE != 0
    if (F.vcu == 1 && F.wave == 0 && F.lane == 0) P.out[(size_t)8 * D] = TS_SCALE * __hip_atomic_load((float*)(P.ws + WS_CTL) + 2048, __ATOMIC_RELAXED, __HIP_MEMORY_SCOPE_AGENT);
#endif
}
template <int MODE> __device__ __forceinline__ void rs_prepass(const pg8::StaticOrder& S, const float* ss, LAS float* tab) {
    int tid = threadIdx.x; asm volatile("" : "+v"(tid));
    pg8::Unit u;
    for (int i = 0; i < TAB_UNITS && S.next(i, u); ++i)
        for (int r = tid; r < 256; r += NWAVES * 64) { const int row = u.pm * 256 + r;
            const f32x4* p = (const f32x4*)(ss + (size_t)row * 16); const f32x4 a = p[0], b = p[1], c = p[2], d = p[3];
            const float s0 = ((a[0] + a[1]) + (a[2] + a[3])) + ((b[0] + b[1]) + (b[2] + b[3])), s1 = ((c[0] + c[1]) + (c[2] + c[3])) + ((d[0] + d[1]) + (d[2] + d[3]));
            if (MODE == 0) tab[i * 256 + r] = __builtin_amdgcn_rsqf((s0 + s1) * (1.0f / 1024.0f) + EPS);
            else { const float ra = __builtin_amdgcn_rsqf(s0 * (1.0f / 512.0f) + EPS), rb = __builtin_amdgcn_rsqf(s1 * (1.0f / 512.0f) + EPS); pg8::f32x2 v; v[0] = ra * __builtin_amdgcn_rcpf(rb); v[1] = rb; ((LAS pg8::f32x2*)tab)[i * 256 + r] = v; } }
    __syncthreads();
}

struct Args { const float* in[12]; float* out; unsigned char* ws; int ph_lo, ph_hi, li, pad; };
__global__ void __launch_bounds__(NWAVES * 64, 2) mk_fwd(Args args) {
    extern __shared__ __attribute__((aligned(16))) unsigned char lds[];
    Frame F;
    F.lds = (LAS unsigned char*)lds;
    F.MISC = (volatile LAS unsigned*)(F.lds + MISC_OFF);
    F.tid = threadIdx.x; F.lane = F.tid & 63; F.wave = __builtin_amdgcn_readfirstlane(F.tid >> 6);
    F.G = gridDim.x; { const int bx = blockIdx.x; F.vcu = (F.G % 8 == 0) ? (bx % 8) * (F.G / 8) + bx / 8 : bx; }
    unsigned char* ws = args.ws;
    F.ctl = (gu32*)(ws + WS_CTL);
    Ptrs P; P.x = args.in[0]; P.g_mix = args.in[1]; P.w_in = args.in[2]; P.g_out_dil = args.in[3]; P.g_out_win = args.in[4]; P.sink = args.in[5]; P.w_out = args.in[6];
    P.g_ffn = args.in[7]; P.w_gate = args.in[8]; P.w_up = args.in[9]; P.w_down = args.in[10]; P.g_final = args.in[11]; P.out = args.out; P.ws = ws;
    for (int u = F.tid; u < (LDS_BYTES - LDSCTL_OFF) / 4; u += NWAVES * 64) ((LAS unsigned*)(F.lds + LDSCTL_OFF))[u] = 0u;
    __syncthreads();
    XcdBarrier bar; bar.bar = (unsigned*)(F.ctl + CW_BAR); bar.x = 0; bar.st = nullptr;
    if (MK_ONE_LAUNCH) bar = xcd_barrier_post((unsigned*)(F.ctl + CW_BAR), F.MISC + 8);
    const int lo = args.ph_lo, hi = args.ph_hi;
    const int inproj_units = (M / 256) * (IN_COLS / 256), tail_first = inproj_units % F.G; const bool tail_conv = false && MK_ONE_LAUNCH && DEPTH == 2 && tail_first != 0 && (F.G - tail_first) * 2 >= F.G / 2;
#define IN(k) (lo <= (k) && (k) < hi)
#if defined(TS_PROBE) && TS_PROBE >= 100
#define PH_T0(k) unsigned long long pt0_ = 0; if (TS_PROBE - 100 == (k) && F.vcu == 1 && threadIdx.x == 0) pt0_ = __builtin_amdgcn_s_memrealtime();
#define PH_T1(k) if (TS_PROBE - 100 == (k) && F.vcu == 1 && threadIdx.x == 0) atomicAdd((float*)(ws + WS_CTL) + 2048, (float)(__builtin_amdgcn_s_memrealtime() - pt0_));
#else
#define PH_T0(k)
#define PH_T1(k)
#endif
#define SEAM(k) do { if (MK_ONE_LAUNCH && IN(k) && IN((k) + 1)) xcd_barrier(bar); } while (0)
    bf16* XB = (bf16*)(ws + WS_XB); bf16* PROJ = (bf16*)(ws + WS_PROJ); bf16* Y = (bf16*)(ws + WS_Y); bf16* ACT = (bf16*)(ws + WS_ACT);
    float* SS_MIX = (float*)(ws + WS_SS_MIX); float* SSY = (float*)(ws + WS_SSY); float* SS_FFN = (float*)(ws + WS_SS_FFN); LAS float* TAB = (LAS float*)(F.lds + TAB_OFF);

    { PH_T0(0) if (IN(0)) { p0_prologue(F, P, !tail_conv); if (MK_DUP == 9) p0_prologue(F, P, !tail_conv); } SEAM(0); PH_T1(0) }
    for (int L = 0; L < DEPTH; ++L) {
        const int pb = 1 + 5 * L;
        const unsigned char* wl = ws + WS_W + (size_t)L * W_LAYER;
        { PH_T0(pb)
        for (int rep_ = 0; rep_ < (MK_DUP == 0 ? 2 : 1); ++rep_)
        if (IN(pb)) {
            pg8::Gemm g{XB, (const bf16*)(wl + W_IN), M, IN_COLS, D}; pg8::StaticOrder S; S.init(M, IN_COLS, F.G, (int)blockIdx.x);
            rs_prepass<0>(S, SS_MIX, TAB); pg8::EpiProj E{PROJ, IN_COLS, TAB};
            pg8::gemm_phase<pg8::EpiProj, pg8::StaticOrder, true, true>(F.lds + RING_OFF, g, S, E);
            if (tail_conv && L == 0 && (int)blockIdx.x >= tail_first) p0_weights_in_tail(F, P, 1, tail_first, F.G - tail_first);
        } SEAM(pb); PH_T1(pb) }
        { PH_T0(pb + 1)
        for (int rep_ = 0; rep_ < (MK_DUP == 1 ? 2 : 1); ++rep_)
        if (IN(pb + 1)) { att::phase(PROJ, P.sink + L * 8, Y, SSY, ws + WS_ATT, F.lds + RING_OFF, F.vcu, F.G, (float*)(ws + WS_CTL) + 2048); } SEAM(pb + 1); PH_T1(pb + 1) }
        { PH_T0(pb + 2)
        for (int rep_ = 0; rep_ < ((MK_DUP == 2 && L == 0) ? 2 : 1); ++rep_)
        if (IN(pb + 2)) {
            pg8::Gemm g{Y, (const bf16*)(wl + W_OUT), M, D, D}; pg8::StaticOrder S; S.init(M, D, F.G, (int)blockIdx.x);
            rs_prepass<1>(S, SSY, TAB); pg8::EpiRes<true> E{XB, SS_FFN, (const LAS pg8::f32x2*)TAB};
            pg8::gemm_phase<pg8::EpiRes<true>, pg8::StaticOrder, true, true>(F.lds + RING_OFF, g, S, E);
        } SEAM(pb + 2); PH_T1(pb + 2) }
        { PH_T0(pb + 3)
        for (int rep_ = 0; rep_ < (MK_DUP == 3 ? 2 : 1); ++rep_)
        if (IN(pb + 3)) {
            pg8::Gemm g{XB, (const bf16*)(wl + W_GU), M, GU, D}; pg8::StaticOrder S; S.init(M, GU, F.G, (int)blockIdx.x);
            rs_prepass<0>(S, SS_FFN, TAB); pg8::EpiSwiglu E{ACT, FF, TAB};
            pg8::gemm_phase<pg8::EpiSwiglu, pg8::StaticOrder, GU_ALIGN, GU_SP2>(F.lds + RING_OFF, g, S, E);
        } SEAM(pb + 3); PH_T1(pb + 3) }
        { PH_T0(pb + 4)
        if (IN(pb + 4)) {
            pg8::Gemm g{ACT, (const bf16*)(wl + W_DOWN), M, D, FF}; pg8::StaticOrder S; S.init(M, D, F.G, (int)blockIdx.x);
            pg8::EpiRes<false> E{XB, SS_MIX, nullptr};
            pg8::gemm_phase<pg8::EpiRes<false>, pg8::StaticOrder, true, true>(F.lds + RING_OFF, g, S, E);
        } SEAM(pb + 4); PH_T1(pb + 4) }
    }
    if (IN(11)) { final_norm(F, P); }
#undef IN
#undef SEAM
}

extern "C" void kernel_launch(void* const* d_in, const int* in_sizes, int n_in, void* d_out, int out_size, void* d_ws, size_t ws_size, hipStream_t stream) {
    static int grid = 0;
    if (grid == 0) {
        if (n_in != 12 || in_sizes[0] != M * D || out_size != M * D || ws_size < WS_END) { fprintf(stderr, "kernel_launch: unexpected sizes (n_in %d, in0 %d, out %d, ws %zu); nothing launched\n", n_in, n_in > 0 ? in_sizes[0] : -1, out_size, ws_size); grid = -1; return; }
        int dev = 0, cus = 0, per_cu = 0;
        if (hipGetDevice(&dev) != hipSuccess || hipDeviceGetAttribute(&cus, hipDeviceAttributeMultiprocessorCount, dev) != hipSuccess) { fprintf(stderr, "kernel_launch: device query failed\n"); grid = -1; return; }
        if (hipFuncSetAttribute((const void*)mk_fwd, hipFuncAttributeMaxDynamicSharedMemorySize, LDS_BYTES) != hipSuccess) { fprintf(stderr, "kernel_launch: hipFuncSetAttribute failed\n"); grid = -1; return; }
        if (hipOccupancyMaxActiveBlocksPerMultiprocessor(&per_cu, (const void*)mk_fwd, NWAVES * 64, LDS_BYTES) != hipSuccess || per_cu < 1) { fprintf(stderr, "kernel_launch: occupancy query reports %d workgroups per CU\n", per_cu); (void)hipGetLastError(); grid = -1; return; }
        grid = cus;
        if ((long)grid * TAB_UNITS < (long)(M / 256) * (GU / 256)) { fprintf(stderr, "kernel_launch: %d workgroups cannot hold the per-unit row-scale tables of the gate/up phase in LDS\n", grid); grid = -1; return; }
    }
    if (grid < 0) return;
    if (hipMemsetAsync((char*)d_ws + WS_CTL, 0, CTL_ZERO_BYTES, stream) != hipSuccess) { fprintf(stderr, "kernel_launch: memset failed\n"); return; }
    Args a{};
    for (int i = 0; i < 12; ++i) a.in[i] = (const float*)d_in[i];
    a.out = (float*)d_out; a.ws = (unsigned char*)d_ws;
#if MK_ONE_LAUNCH
    a.ph_lo = 0; a.ph_hi = NPHASE; a.li = 0;
    hipLaunchKernelGGL(mk_fwd, dim3(grid), dim3(NWAVES * 64), LDS_BYTES, stream, a);
#else
    for (int p = 0; p < NPHASE; ++p) { a.ph_lo = p; a.ph_hi = p + 1; a.li = p; hipLaunchKernelGGL(mk_fwd, dim3(grid), dim3(NWAVES * 64), LDS_BYTES, stream, a); }
#endif
    const hipError_t le = hipPeekAtLastError();
    if (le != hipSuccess) fprintf(stderr, "kernel_launch: launch failed: %s\n", hipGetErrorName(le));
}
```
